# Optimizing an MI355X kernel written in HIP

```python
import math
import jax, jax.numpy as jnp
from jax import lax
import numpy as np

D_MODEL = 1024
BATCH = 32
SEQ = 256
DEPTH = 1
DEC_BATCH = 4
DEC_SEQ = 1024
PAST_LEN = 256

GRID_W = 64
D_HYENA = 1024
N_HEADS = 16
HEAD_DIM = 64
D_ATTN = N_HEADS * HEAD_DIM
WIN_ROWS_MAX = 8
WIN_COLS = 16
FILTER_EMB = 33
FILTER_BANDS = (FILTER_EMB - 1) // 2
FILTER_HIDDEN = 64
DECAY_TARGET = 1e-2
FAST_DECAY_PCT = 0.3
SLOW_DECAY_PCT = 1.5
MIN_DECAY = math.log(DECAY_TARGET) / SLOW_DECAY_PCT
MAX_DECAY = math.log(DECAY_TARGET) / FAST_DECAY_PCT
DECAY_SHIFT = 0.05
LN_EPS = 1e-5
ALPHA = (2.0 * DEPTH) ** 0.25
BETA = (8.0 * DEPTH) ** -0.25
D_IN = 4 * D_HYENA + 4 * D_ATTN + 2 * D_MODEL
NEG_INF = -1e30

kernel_name = "hyena_natten_gated_deepnorm_step"


def layer_norm(x, g, b):
    xf = x.astype(jnp.float32)
    mu = xf.mean(-1, keepdims=True)
    var = jnp.square(xf - mu).mean(-1, keepdims=True)
    return ((xf - mu) * lax.rsqrt(var + LN_EPS)).astype(x.dtype) * g + b


def modulation(cond, w_ada, b_ada):
    mod = jax.nn.silu(cond) @ w_ada + b_ada
    return jnp.split(mod, 3, axis=-1)


def short_conv(u, w, b):
    L = u.shape[1]
    up = jnp.pad(u, ((0, 0), (1, 1), (0, 0)))
    return up[:, :L] * w[0] + up[:, 1:L + 1] * w[1] + up[:, 2:L + 2] * w[2] + b


def split_projection(h, w_in, conv_w, conv_b):
    B, L, _ = h.shape
    z = h @ w_in
    hy, g_h, qkv, g_a, m = jnp.split(
        z, [3 * D_HYENA, 4 * D_HYENA, 4 * D_HYENA + 3 * D_ATTN, 4 * D_HYENA + 4 * D_ATTN], axis=-1)
    hy = short_conv(hy, conv_w, conv_b)
    v_h, x1, x0 = jnp.split(hy, 3, axis=-1)
    q, k, v = [t.reshape(B, L, N_HEADS, HEAD_DIM) for t in jnp.split(qkv, 3, axis=-1)]
    return (v_h, x1, x0, g_h), (q, k, v, g_a), m


def hyena_filters(L, f_w1, f_b1, f_w2, f_b2, f_w3, f_freq):
    t = jnp.linspace(0.0, 1.0, L, dtype=jnp.float32)[:, None]
    bands = jnp.linspace(1e-4, FILTER_BANDS - 1, FILTER_BANDS, dtype=jnp.float32)[None]
    w = 2.0 * math.pi * jnp.arange(L, dtype=jnp.float32)[:, None] / L
    z = jnp.concatenate([t, jnp.cos(bands * w), -jnp.sin(bands * w)], axis=-1)
    hf = jnp.sin(f_freq[0] * (z @ f_w1 + f_b1))
    hf = jnp.sin(f_freq[1] * (hf @ f_w2 + f_b2))
    hf = (hf @ f_w3).astype(jnp.float32).reshape(L, 2, D_HYENA)
    deltas = jnp.linspace(MIN_DECAY, MAX_DECAY, D_HYENA, dtype=jnp.float32)
    decay = jnp.exp(-t * jnp.abs(deltas)) + DECAY_SHIFT
    hf = hf * decay[:, None, :]
    return hf[:, 0], hf[:, 1]


def hyena_long_conv(v_h, x1, x0, h_fwd, h_bwd, d_bias):
    L = v_h.shape[1]
    u = v_h * x1
    filt_full = jnp.concatenate([h_fwd, jnp.zeros_like(h_fwd[:1]), h_bwd[:0:-1]], axis=0)
    n = 2 * L
    uf = jnp.fft.rfft(u.astype(jnp.float32), n=n, axis=1)
    ff = jnp.fft.rfft(filt_full, n=n, axis=0)
    y = jnp.fft.irfft(uf * ff[None], n=n, axis=1)[:, :L].astype(u.dtype)
    return (y + u * d_bias) * x0


def context_attention(q, k, v):
    B, L, H, Dh = q.shape
    s = jnp.einsum("bqhd,bkhd->bhqk", q, k).astype(jnp.float32) * (HEAD_DIM ** -0.5)
    p = jax.nn.softmax(s, axis=-1).astype(v.dtype)
    return jnp.einsum("bhqk,bkhd->bqhd", p, v).reshape(B, L, H * Dh)


def neighbourhood_attention(q, k, v, ctx_k, ctx_v, rpb):
    B, L, H, Dh = q.shape
    rows = L // GRID_W
    kh = min(WIN_ROWS_MAX, rows)
    kw = WIN_COLS
    r = jnp.arange(rows)
    col = jnp.arange(GRID_W)
    r0 = jnp.clip(r - kh // 2, 0, rows - kh)
    c0 = jnp.clip(col - kw // 2, 0, GRID_W - kw)
    slab_rows = r0[:, None] + jnp.arange(kh)[None]
    n_slab = kh * GRID_W
    kg = k.reshape(B, rows, GRID_W, H, Dh)[:, slab_rows].reshape(B, rows, n_slab, H, Dh)
    vg = v.reshape(B, rows, GRID_W, H, Dh)[:, slab_rows].reshape(B, rows, n_slab, H, Dh)
    qg = q.reshape(B, rows, GRID_W, H, Dh)
    scale = HEAD_DIM ** -0.5
    s_win = jnp.einsum("brqhd,brkhd->bhrqk", qg, kg).astype(jnp.float32) * scale
    key_row = jnp.broadcast_to(slab_rows[:, :, None], (rows, kh, GRID_W)).reshape(rows, n_slab)
    key_col = jnp.tile(col, kh)
    dr = key_row[:, None, :] - r[:, None, None]
    dc = key_col[None, None, :] - col[None, :, None]
    in_win = (key_col[None, :] >= c0[:, None]) & (key_col[None, :] < c0[:, None] + kw)
    bias = rpb[:, dr + WIN_ROWS_MAX - 1, jnp.clip(dc + WIN_COLS - 1, 0, 2 * WIN_COLS - 2)]
    s_win = jnp.where(in_win[None, None, None], s_win + bias[None].astype(jnp.float32), NEG_INF)
    s_ctx = jnp.einsum("brqhd,bkhd->bhrqk", qg, ctx_k).astype(jnp.float32) * scale
    p = jax.nn.softmax(jnp.concatenate([s_win, s_ctx], axis=-1), axis=-1).astype(v.dtype)
    o = (jnp.einsum("bhrqk,brkhd->brqhd", p[..., :n_slab], vg)
         + jnp.einsum("bhrqk,bkhd->brqhd", p[..., n_slab:], ctx_v))
    return o.reshape(B, L, H * Dh)


def merge_branches(y_h, g_h, y_a, g_a, m, w_bh, w_ba, w_out):
    p_h = (y_h * jax.nn.silu(g_h)) @ w_bh
    p_a = (y_a * jax.nn.silu(g_a)) @ w_ba
    m_h, m_a = jnp.split(jax.nn.sigmoid(m), 2, axis=-1)
    return (m_h * p_h + m_a * p_a) @ w_out


def layer_forward(x, cond, ctx_kv, p):
    shift, scale, gate = modulation(cond, p["w_ada"], p["b_ada"])
    h = x * (1 + scale) + shift
    (v_h, x1, x0, g_h), (q, k, v, g_a), m = split_projection(h, p["w_in"], p["conv_w"], p["conv_b"])
    h_fwd, h_bwd = hyena_filters(x.shape[1], p["filt_w1"], p["filt_b1"], p["filt_w2"],
                                 p["filt_b2"], p["filt_w3"], p["filt_freq"])
    y_h = hyena_long_conv(v_h, x1, x0, h_fwd, h_bwd, p["hyena_d"])
    if ctx_kv is None:
        y_a = context_attention(q, k, v)
        kv_out = (k, v)
    else:
        y_a = neighbourhood_attention(q, k, v, ctx_kv[0], ctx_kv[1], p["rpb"])
        kv_out = None
    out = merge_branches(y_h, g_h, y_a.reshape(g_a.shape), g_a, m, p["w_bh"], p["w_ba"], p["w_out"])
    x_new = layer_norm(ALPHA * x + gate * out, p["ln_g"], p["ln_b"])
    return x_new, kv_out


def setup_inputs(seed: int = 0) -> dict:
    key = jax.random.key(seed)
    ks = jax.random.split(key, 24)

    def nrm(k, shape, s):
        return jax.random.normal(k, shape, jnp.float32) * s

    return {
        "x_prompt": nrm(ks[0], (BATCH, SEQ, D_MODEL), 1.0),
        "x_sample": nrm(ks[1], (DEC_BATCH, DEC_SEQ, D_MODEL), 1.0),
        "c": nrm(ks[2], (DEC_BATCH, D_MODEL), 1.0),
        "cache_k": nrm(ks[3], (DEC_BATCH, DEPTH, PAST_LEN, N_HEADS, HEAD_DIM), 1.0),
        "cache_v": nrm(ks[4], (DEC_BATCH, DEPTH, PAST_LEN, N_HEADS, HEAD_DIM), 1.0),
        "c_ctx": nrm(ks[5], (D_MODEL,), 1.0),
        "w_ada": nrm(ks[6], (DEPTH, D_MODEL, 3 * D_MODEL), 0.5 * D_MODEL ** -0.5),
        "b_ada": nrm(ks[7], (DEPTH, 3 * D_MODEL), 0.02),
        "w_in": nrm(ks[8], (DEPTH, D_MODEL, D_IN), D_MODEL ** -0.5),
        "conv_w": nrm(ks[9], (DEPTH, 3, 3 * D_HYENA), 0.5),
        "conv_b": nrm(ks[10], (DEPTH, 3 * D_HYENA), 0.02),
        "filt_w1": nrm(ks[11], (DEPTH, FILTER_EMB, FILTER_HIDDEN), FILTER_EMB ** -0.5),
        "filt_b1": nrm(ks[12], (DEPTH, FILTER_HIDDEN), 0.1),
        "filt_w2": nrm(ks[13], (DEPTH, FILTER_HIDDEN, FILTER_HIDDEN), FILTER_HIDDEN ** -0.5),
        "filt_b2": nrm(ks[14], (DEPTH, FILTER_HIDDEN), 0.1),
        "filt_w3": nrm(ks[15], (DEPTH, FILTER_HIDDEN, 2 * D_HYENA), 0.1 * FILTER_HIDDEN ** -0.5),
        "filt_freq": 1.0 + nrm(ks[16], (DEPTH, 2, FILTER_HIDDEN), 0.1),
        "hyena_d": nrm(ks[17], (DEPTH, D_HYENA), 0.5),
        "rpb": nrm(ks[18], (DEPTH, N_HEADS, 2 * WIN_ROWS_MAX - 1, 2 * WIN_COLS - 1), 0.1),
        "w_bh": nrm(ks[19], (DEPTH, D_HYENA, D_MODEL), BETA * D_HYENA ** -0.5),
        "w_ba": nrm(ks[20], (DEPTH, D_ATTN, D_MODEL), BETA * D_ATTN ** -0.5),
        "w_out": nrm(ks[21], (DEPTH, D_MODEL, D_MODEL), BETA * D_MODEL ** -0.5),
        "ln_g": 1.0 + nrm(ks[22], (DEPTH, D_MODEL), 0.01),
        "ln_b": nrm(ks[23], (DEPTH, D_MODEL), 0.01),
    }


def reference(x_prompt, x_sample, c, cache_k, cache_v, c_ctx, w_ada, b_ada, w_in, conv_w, conv_b,
              filt_w1, filt_b1, filt_w2, filt_b2, filt_w3, filt_freq, hyena_d, rpb,
              w_bh, w_ba, w_out, ln_g, ln_b):
    xp = x_prompt
    xs = x_sample
    cond_lat = c[:, None, :]
    new_k = []
    new_v = []
    for l in range(DEPTH):
        p = {
            "w_ada": w_ada[l], "b_ada": b_ada[l], "w_in": w_in[l],
            "conv_w": conv_w[l], "conv_b": conv_b[l],
            "filt_w1": filt_w1[l], "filt_b1": filt_b1[l], "filt_w2": filt_w2[l],
            "filt_b2": filt_b2[l], "filt_w3": filt_w3[l], "filt_freq": filt_freq[l],
            "hyena_d": hyena_d[l], "rpb": rpb[l],
            "w_bh": w_bh[l], "w_ba": w_ba[l], "w_out": w_out[l],
            "ln_g": ln_g[l], "ln_b": ln_b[l],
        }
        xp, (k_ctx, v_ctx) = layer_forward(xp, c_ctx, None, p)
        new_k.append(k_ctx)
        new_v.append(v_ctx)
        xs, _ = layer_forward(xs, cond_lat, (cache_k[:, l], cache_v[:, l]), p)
    return (xp, xs, jnp.stack(new_k, axis=1), jnp.stack(new_v, axis=1))
```

```cpp
#include <hip/hip_runtime.h>
#include <cstdio>
#include <cstdint>
#include <cmath>
namespace pg8 {
#define PG8_LAS __attribute__((address_space(3)))
typedef unsigned short bf16_t;
typedef short bf16x8 __attribute__((ext_vector_type(8)));
typedef float f32x4 __attribute__((ext_vector_type(4)));
typedef unsigned u32x4 __attribute__((ext_vector_type(4)));
constexpr int BM = 256, BK = 64, HALF = 128, HTB = HALF * BK * 2  , STAGE_BYTES = 8 * HTB, NXCD = 8, WGM = 8;

__host__ __device__ __forceinline__ int lds_byte(int r, int c) { const int st = (r >> 4) * 2 + (c >> 5), rr = r & 15, cc = c & 31, ob = rr * 64 + cc * 2; return st * 1024 + (ob ^ (((ob >> 9) & 1) << 5)); }
__host__ __device__ __forceinline__ void stage_rc(int b, int& R, int& C) { const int st = b / 1024, sb = b % 1024, swz = sb ^ (((sb >> 9) & 1) << 5); R = (st >> 1) * 16 + swz / 64; C = (st & 1) * 32 + (swz % 64) / 2; }
__host__ __device__ __forceinline__ int perm32(int rho) { const int n = rho >> 4, i = rho & 15; return 8 * (i >> 2) + 4 * n + (i & 3); }

struct Unit { int pm, pn; };
struct Gemm { const bf16_t* A; const bf16_t* Bt; int M, N, K; };

struct StaticOrder {
    int nM, nN, nwg, G, c;
    __host__ __device__ void init(int M, int N, int G_, int c_) { nM = M / BM; nN = N / BM; nwg = nM * nN; G = G_; c = c_; }
    __host__ __device__ bool next(int i, Unit& u) const {
        const long L = (long)i * G + c; if (L >= nwg) return false;
        int wgid = (int)L; { const int q = nwg / NXCD, r = nwg % NXCD, xcd = wgid % NXCD, off = wgid / NXCD; wgid = (xcd < r ? xcd * (q + 1) : r * (q + 1) + (xcd - r) * q) + off; }
        const int nig = WGM * nN, gid = wgid / nig, fm = gid * WGM, gsz = (nM - fm) < WGM ? (nM - fm) : WGM;
        u.pm = fm + ((wgid % nig) % gsz); u.pn = (wgid % nig) / gsz; return true;
    }
    __device__ __forceinline__ void a_ready(const Unit&) const {}
    __device__ __forceinline__ void done(const Unit&) const {}
};

__device__ __forceinline__ unsigned cvt_pk_bf16(float lo, float hi) { unsigned r; asm volatile("v_cvt_pk_bf16_f32 %0, %1, %2" : "=v"(r) : "v"(lo), "v"(hi)); return r; }
typedef float f32x2 __attribute__((ext_vector_type(2)));
__device__ __forceinline__ f32x2 gelu_pk(f32x2 v) {
    const f32x2 av = __builtin_elementwise_abs(v), d = av * 0.2316418882f + 1.0f;
    f32x2 t; t.x = __builtin_amdgcn_rcpf(d.x); t.y = __builtin_amdgcn_rcpf(d.y);
    f32x2 q = t * 0.5307027145f + (-0.7265760135f); q = q * t + 0.7107068705f; q = q * t + (-0.142248368f); q = q * t + 0.127414796f; q = q * t;
    const f32x2 s = (v * v) * (-0.72134752044f);
    f32x2 e; e.x = __builtin_amdgcn_exp2f(s.x); e.y = __builtin_amdgcn_exp2f(s.y);
    const f32x2 m = v * (q * e), r = v - m;
    f32x2 o; o.x = v.x < 0.f ? m.x : r.x; o.y = v.y < 0.f ? m.y : r.y; return o;
}

typedef unsigned u32x2e __attribute__((ext_vector_type(2)));
__device__ __forceinline__ float sigmoid_f(float x) { return __builtin_amdgcn_rcpf(1.0f + __builtin_amdgcn_exp2f(-1.4426950408889634f * x)); }
constexpr int EP_M = 12288;
constexpr size_t EP_PLANE = (size_t)EP_M * 1024;
struct EpiProj {
    static constexpr bool PERM = true, AFTER_DRAIN = false;
    bf16_t* planes;
    bf16_t* mplanes;
    float* newk; float* newv;
    float qscale;
    __device__ __forceinline__ void operator()(const f32x4 (&acc)[2][2][4][2], const Unit& u, int wr, int wc, int fr, int fq) const {
        const int t = u.pn >> 2;
        const int row0 = u.pm * BM + wr * 64 + fr, colp0 = (u.pn & 3) * BM + wc * 32 + 8 * fq;
        bf16_t* base = (t < 8) ? planes + (size_t)t * EP_PLANE : mplanes + (size_t)(t - 8) * EP_PLANE;
        const bool chunk = t < 4;
        const int mode = (t == 3 || t == 7) ? 1 : (t >= 8 ? 2 : (t == 4 ? 3 : 0));
        float* f32o = (u.pm < 32) ? (t == 5 ? newk : (t == 6 ? newv : nullptr)) : nullptr;
#pragma unroll
        for (int ai = 0; ai < 2; ++ai)
#pragma unroll
            for (int m = 0; m < 4; ++m) { const int row = row0 + ai * HALF + m * 16;
#pragma unroll
                for (int bj = 0; bj < 2; ++bj) { const int col = colp0 + bj * HALF;
                    f32x4 v0 = acc[ai][bj][m][0], v1 = acc[ai][bj][m][1];
                    if (f32o) { float* p = f32o + (size_t)row * 1024 + col; *(f32x4*)p = v0; *(f32x4*)(p + 4) = v1; }
                    if (mode == 1) {
#pragma unroll
                        for (int e = 0; e < 4; ++e) { v0[e] = v0[e] * sigmoid_f(v0[e]); v1[e] = v1[e] * sigmoid_f(v1[e]); }
                    } else if (mode == 2) {
#pragma unroll
                        for (int e = 0; e < 4; ++e) { v0[e] = sigmoid_f(v0[e]); v1[e] = sigmoid_f(v1[e]); }
                    } else if (mode == 3) { v0 = v0 * qscale; v1 = v1 * qscale; }
                    u32x4 w; w.x = cvt_pk_bf16(v0[0], v0[1]); w.y = cvt_pk_bf16(v0[2], v0[3]); w.z = cvt_pk_bf16(v1[0], v1[1]); w.w = cvt_pk_bf16(v1[2], v1[3]);
                    bf16_t* dst = chunk ? base + ((size_t)(col >> 3) * EP_M + row) * 8 : base + (size_t)row * 1024 + col;
                    *(u32x4*)dst = w; } }
    }
};
__device__ __forceinline__ float bf_lo(unsigned w) { return __uint_as_float(w << 16); }
__device__ __forceinline__ float bf_hi(unsigned w) { return __uint_as_float(w & 0xffff0000u); }
struct EpiGate {
    static constexpr bool PERM = true, AFTER_DRAIN = false;
    const bf16_t* gate; const bf16_t* prev; bf16_t* O;
    __device__ __forceinline__ void operator()(const f32x4 (&acc)[2][2][4][2], const Unit& u, int wr, int wc, int fr, int fq) const {
        const int row0 = u.pm * BM + wr * 64 + fr, col0 = u.pn * BM + wc * 32 + 8 * fq;
#pragma unroll
        for (int ai = 0; ai < 2; ++ai)
#pragma unroll
            for (int m = 0; m < 4; ++m) { const size_t ro = (size_t)(row0 + ai * HALF + m * 16) * 1024 + col0;
#pragma unroll
                for (int bj = 0; bj < 2; ++bj) { const size_t o = ro + bj * HALF;
                    const u32x4 g = *(const u32x4*)(gate + o);
                    f32x4 v0 = acc[ai][bj][m][0], v1 = acc[ai][bj][m][1];
                    v0[0] *= bf_lo(g.x); v0[1] *= bf_hi(g.x); v0[2] *= bf_lo(g.y); v0[3] *= bf_hi(g.y);
                    v1[0] *= bf_lo(g.z); v1[1] *= bf_hi(g.z); v1[2] *= bf_lo(g.w); v1[3] *= bf_hi(g.w);
                    if (prev) { const u32x4 p = *(const u32x4*)(prev + o);
                        v0[0] += bf_lo(p.x); v0[1] += bf_hi(p.x); v0[2] += bf_lo(p.y); v0[3] += bf_hi(p.y);
                        v1[0] += bf_lo(p.z); v1[1] += bf_hi(p.z); v1[2] += bf_lo(p.w); v1[3] += bf_hi(p.w); }
                    u32x4 w; w.x = cvt_pk_bf16(v0[0], v0[1]); w.y = cvt_pk_bf16(v0[2], v0[3]); w.z = cvt_pk_bf16(v1[0], v1[1]); w.w = cvt_pk_bf16(v1[2], v1[3]);
                    *(u32x4*)(O + o) = w; } }
    }
};
struct EpiResid {
    static constexpr bool PERM = true, AFTER_DRAIN = false;
    const float* xp; const float* xs; const float* mod; float* V; float alpha;
    __device__ __forceinline__ void operator()(const f32x4 (&acc)[2][2][4][2], const Unit& u, int wr, int wc, int fr, int fq) const {
        const int row0 = u.pm * BM + wr * 64 + fr, col0 = u.pn * BM + wc * 32 + 8 * fq;
        const int cond = (u.pm < 32) ? 0 : 1 + ((u.pm - 32) >> 2);
        const float* x = (u.pm < 32) ? xp : xs - (size_t)8192 * 1024;
        f32x4 g[2][2];
#pragma unroll
        for (int bj = 0; bj < 2; ++bj) { g[bj][0] = *(const f32x4*)(mod + cond * 3072 + 2048 + col0 + bj * HALF); g[bj][1] = *(const f32x4*)(mod + cond * 3072 + 2048 + col0 + bj * HALF + 4); }
#pragma unroll
        for (int ai = 0; ai < 2; ++ai)
#pragma unroll
            for (int m = 0; m < 4; ++m) { const size_t ro = (size_t)(row0 + ai * HALF + m * 16) * 1024 + col0;
#pragma unroll
                for (int bj = 0; bj < 2; ++bj) { const size_t o = ro + bj * HALF;
                    const f32x4 x0 = *(const f32x4*)(x + o), x1 = *(const f32x4*)(x + o + 4);
                    *(f32x4*)(V + o) = x0 * alpha + g[bj][0] * acc[ai][bj][m][0];
                    *(f32x4*)(V + o + 4) = x1 * alpha + g[bj][1] * acc[ai][bj][m][1]; } }
    }
};
template <class Epi, class Sched, bool ALIGN_EPI = false, bool SP2 = false>
__device__ __forceinline__ void gemm_phase(PG8_LAS unsigned char* lds, const Gemm g, const Sched& S, const Epi& E) {
    const int tid = threadIdx.x, wid = __builtin_amdgcn_readfirstlane(tid >> 6), lane = tid & 63, wr = wid >> 2, wc = wid & 3, fr = lane & 15, fq = lane >> 4;
    const int K = g.K, nt = K / BK;
    unsigned voffA[2], voffB[2];
#pragma unroll
    for (int i = 0; i < 2; ++i) { int R, C; stage_rc(tid * 16 + i * 8192, R, C); const int Rb = Epi::PERM ? ((R & ~31) + perm32(R & 31)) : R;
        voffA[i] = (unsigned)(R * K + C) * 2u; voffB[i] = (unsigned)(Rb * K + C) * 2u; }
    const size_t kstep = (size_t)(BK * 2);
    const size_t hstep = (size_t)HALF * K * 2;
    const size_t tstep = 2 * hstep;
    const unsigned ldsw = (unsigned)wid * 1024u;
    const int aoff = lds_byte(wr * 64 + fr, fq * 8), boff = lds_byte(wc * 32 + fr, fq * 8);
#define PG8_SA(b, h) (((b) * 2 + (h)) * HTB)
#define PG8_SB(b, h) ((4 + (b) * 2 + (h)) * HTB)
#define PG8_STAGE(bufoff, gbase, voff) do { _Pragma("unroll") for (int _i = 0; _i < 2; ++_i) \
        __builtin_amdgcn_global_load_lds((const unsigned*)((const char*)(gbase) + (voff)[_i]), (PG8_LAS unsigned*)(lds + (bufoff) + ldsw + _i * 8192), 16, 0, 0); } while (0)
#define PG8_LDA(dst, b, h) do { _Pragma("unroll") for (int m = 0; m < 4; ++m) _Pragma("unroll") for (int k = 0; k < 2; ++k) dst[m][k] = *(const PG8_LAS bf16x8*)(lds + PG8_SA(b, h) + aoff + m * 2048 + k * 1024); } while (0)
#define PG8_LDB(dst, b, h) do { _Pragma("unroll") for (int n = 0; n < 2; ++n) _Pragma("unroll") for (int k = 0; k < 2; ++k) dst[n][k] = *(const PG8_LAS bf16x8*)(lds + PG8_SB(b, h) + boff + n * 2048 + k * 1024); } while (0)
#define PG8_MMA(ai, bj, At, Bt) do { __builtin_amdgcn_s_setprio(1); _Pragma("unroll") for (int m = 0; m < 4; ++m) _Pragma("unroll") for (int n = 0; n < 2; ++n) _Pragma("unroll") for (int k = 0; k < 2; ++k) \
        acc[ai][bj][m][n] = __builtin_amdgcn_mfma_f32_16x16x32_bf16(Bt[n][k], At[m][k], acc[ai][bj][m][n], 0, 0, 0); __builtin_amdgcn_s_setprio(0); } while (0)
#define PG8_WAIT_V(n) asm volatile("s_waitcnt vmcnt(" #n ")" ::: "memory")
#define PG8_WAIT_L(n) asm volatile("s_waitcnt lgkmcnt(" #n ")" ::: "memory")
#define PG8_BAR __builtin_amdgcn_s_barrier()
#define PG8_SCHED __builtin_amdgcn_sched_barrier(0)
    Unit cur, nxt; int ui = 0;
    if (!S.next(0, cur)) return;
    f32x4 acc[2][2][4][2];
#pragma unroll
    for (int a = 0; a < 2; ++a)
#pragma unroll
        for (int b = 0; b < 2; ++b)
#pragma unroll
            for (int m = 0; m < 4; ++m)
#pragma unroll
                for (int n = 0; n < 2; ++n) acc[a][b][m][n] = (f32x4){0.f, 0.f, 0.f, 0.f};
    bf16x8 At[4][2], B0[2][2], B1[2][2];
    const char* cA = (const char*)g.A + (size_t)cur.pm * tstep; const char* cB = (const char*)g.Bt + (size_t)cur.pn * tstep;
    S.a_ready(cur);
    if constexpr (SP2) {
        PG8_STAGE(PG8_SB(0, 0), cB, voffB); PG8_STAGE(PG8_SB(0, 1), cB + hstep, voffB); PG8_STAGE(PG8_SA(0, 0), cA, voffA); PG8_STAGE(PG8_SA(0, 1), cA + hstep, voffA);
        if (wr == 1) PG8_BAR;
        PG8_WAIT_V(2); PG8_BAR;
        PG8_STAGE(PG8_SB(1, 0), cB + kstep, voffB); PG8_STAGE(PG8_SA(1, 0), cA + kstep, voffA); PG8_STAGE(PG8_SB(1, 1), cB + hstep + kstep, voffB);
        PG8_WAIT_V(6); PG8_BAR;
    } else {
        PG8_STAGE(PG8_SB(0, 0), cB, voffB); PG8_STAGE(PG8_SA(0, 0), cA, voffA); PG8_STAGE(PG8_SB(0, 1), cB + hstep, voffB); PG8_STAGE(PG8_SA(0, 1), cA + hstep, voffA);
        if (wr == 1) PG8_BAR;
        PG8_WAIT_V(4); PG8_BAR;
        PG8_STAGE(PG8_SB(1, 0), cB + kstep, voffB); PG8_STAGE(PG8_SA(1, 0), cA + kstep, voffA); PG8_STAGE(PG8_SB(1, 1), cB + hstep + kstep, voffB);
        PG8_WAIT_V(6); PG8_BAR;
    }
    for (;;) {
        const bool has_next = S.next(ui + 1, nxt);
        const char* nA = has_next ? (const char*)g.A + (size_t)nxt.pm * tstep : cA; const char* nB = has_next ? (const char*)g.Bt + (size_t)nxt.pn * tstep : cB;
        for (int t = 0; t < nt; t += 2) {
            const bool last = (t == nt - 2);
            const char* a1 = cA + (size_t)(t + 1) * kstep;
            const char* a2 = last ? nA : cA + (size_t)(t + 2) * kstep; const char* b2 = last ? nB : cB + (size_t)(t + 2) * kstep;
            const char* a3 = a2 + kstep; const char* b3 = b2 + kstep;
            if (last && has_next) S.a_ready(nxt);
            if constexpr (SP2) {
            PG8_LDB(B0, 0, 0); PG8_LDB(B1, 0, 1); PG8_SCHED; PG8_LDA(At, 0, 0); PG8_STAGE(PG8_SA(1, 1), a1 + hstep, voffA);
            PG8_WAIT_V(8); PG8_WAIT_L(0); PG8_BAR; PG8_MMA(0, 0, At, B0); PG8_MMA(0, 1, At, B1); PG8_BAR; PG8_SCHED;
            PG8_LDA(At, 0, 1); PG8_STAGE(PG8_SB(0, 0), b2, voffB); PG8_STAGE(PG8_SB(0, 1), b2 + hstep, voffB); PG8_STAGE(PG8_SA(0, 0), a2, voffA);
            PG8_WAIT_V(8); PG8_WAIT_L(0); PG8_BAR; PG8_MMA(1, 0, At, B0); PG8_MMA(1, 1, At, B1); PG8_BAR; PG8_SCHED;
            PG8_LDB(B0, 1, 0); PG8_LDB(B1, 1, 1); PG8_SCHED; PG8_LDA(At, 1, 0); PG8_STAGE(PG8_SA(0, 1), a2 + hstep, voffA);
            PG8_WAIT_V(8); PG8_WAIT_L(0); PG8_BAR; PG8_MMA(0, 0, At, B0); PG8_MMA(0, 1, At, B1); PG8_BAR; PG8_SCHED;
            PG8_LDA(At, 1, 1); PG8_STAGE(PG8_SB(1, 0), b3, voffB); PG8_STAGE(PG8_SB(1, 1), b3 + hstep, voffB); PG8_STAGE(PG8_SA(1, 0), a3, voffA);
            PG8_WAIT_V(8); PG8_WAIT_L(0); PG8_BAR; PG8_MMA(1, 0, At, B0); PG8_MMA(1, 1, At, B1); PG8_BAR; PG8_SCHED;
            } else {
            PG8_LDB(B0, 0, 0); PG8_SCHED; PG8_LDA(At, 0, 0); PG8_STAGE(PG8_SA(1, 1), a1 + hstep, voffA);
            PG8_WAIT_L(8); PG8_BAR; PG8_WAIT_L(0); PG8_MMA(0, 0, At, B0); PG8_BAR; PG8_SCHED;
            PG8_LDB(B1, 0, 1); PG8_STAGE(PG8_SB(0, 0), b2, voffB);
            PG8_BAR; PG8_WAIT_L(0); PG8_MMA(0, 1, At, B1); PG8_BAR;
            PG8_LDA(At, 0, 1); PG8_STAGE(PG8_SA(0, 0), a2, voffA);
            PG8_BAR; PG8_WAIT_L(0); PG8_MMA(1, 0, At, B0); PG8_BAR; PG8_SCHED;
            PG8_STAGE(PG8_SB(0, 1), b2 + hstep, voffB);
            PG8_WAIT_V(6); PG8_BAR; PG8_MMA(1, 1, At, B1); PG8_BAR;
            PG8_LDB(B0, 1, 0); PG8_SCHED; PG8_LDA(At, 1, 0); PG8_STAGE(PG8_SA(0, 1), a2 + hstep, voffA);
            PG8_WAIT_L(8); PG8_BAR; PG8_WAIT_L(0); PG8_MMA(0, 0, At, B0); PG8_BAR; PG8_SCHED;
            PG8_LDB(B1, 1, 1); PG8_STAGE(PG8_SB(1, 0), b3, voffB);
            PG8_BAR; PG8_WAIT_L(0); PG8_MMA(0, 1, At, B1); PG8_BAR;
            PG8_LDA(At, 1, 1); PG8_STAGE(PG8_SA(1, 0), a3, voffA);
            PG8_BAR; PG8_WAIT_L(0); PG8_MMA(1, 0, At, B0); PG8_BAR; PG8_SCHED;
            PG8_STAGE(PG8_SB(1, 1), b3 + hstep, voffB);
            PG8_WAIT_V(6); PG8_BAR; PG8_MMA(1, 1, At, B1); PG8_BAR;
            }
        }
        if constexpr (ALIGN_EPI) { if (wr == 0) PG8_BAR; }
        if constexpr (!Epi::AFTER_DRAIN) { E(acc, cur, wr, wc, fr, fq); S.done(cur); }
        if (!has_next) break;
#pragma unroll
        for (int a = 0; a < 2; ++a)
#pragma unroll
            for (int b = 0; b < 2; ++b)
#pragma unroll
                for (int m = 0; m < 4; ++m)
#pragma unroll
                    for (int n = 0; n < 2; ++n) acc[a][b][m][n] = (f32x4){0.f, 0.f, 0.f, 0.f};
        cur = nxt; cA = nA; cB = nB; ++ui;
        if constexpr (ALIGN_EPI) { if (wr == 1) PG8_BAR; }
    }
    PG8_WAIT_V(0);
    if constexpr (!ALIGN_EPI) { if (wr == 0) PG8_BAR; }
    PG8_BAR;
    if constexpr (Epi::AFTER_DRAIN) { E.fused(acc, cur, wr, wc, fr, fq, lds, wid, lane); S.done(cur); }
#undef PG8_SA
#undef PG8_SB
#undef PG8_STAGE
#undef PG8_LDA
#undef PG8_LDB
#undef PG8_MMA
#undef PG8_WAIT_V
#undef PG8_WAIT_L
#undef PG8_BAR
#undef PG8_SCHED
}
}
#define GAS __attribute__((address_space(1)))
#define LAS __attribute__((address_space(3)))
typedef unsigned short bf16;
typedef unsigned v4u __attribute__((ext_vector_type(4)));
typedef float f32x4 __attribute__((ext_vector_type(4)));
typedef short bf16x8 __attribute__((ext_vector_type(8)));
typedef GAS unsigned gu32;
typedef GAS unsigned long long gu64;
#define RLX_AGENT __ATOMIC_RELAXED, __HIP_MEMORY_SCOPE_AGENT
#define LDS_WAIT() asm volatile("s_waitcnt lgkmcnt(0)" ::: "memory")
#define VM_WAIT() asm volatile("s_waitcnt vmcnt(0)" ::: "memory")
__device__ __forceinline__ unsigned long long rt() { return __builtin_amdgcn_s_memrealtime(); }
__device__ __forceinline__ unsigned f2bf(float f) { unsigned u = __builtin_bit_cast(unsigned, f); return (u + 0x7fffu + ((u >> 16) & 1u)) >> 16; }
__device__ __forceinline__ unsigned pk2(float lo, float hi) { return f2bf(lo) | (f2bf(hi) << 16); }

#define XB_TMO      128
#define XB_XCNT(j)  (256  + 64 * (j))
#define XB_XSUB(j)  (1280 + 64 * (j))
#define XB_XGEN(j)  (2304 + 64 * (j))
#define XB_TOP      3328
#define XB_TOPGEN   3392
#define XCD_BAR_WORDS 3456
#define XB_SPIN_CAP (1u << 18)

__device__ __forceinline__ unsigned xb_ld(unsigned* p)              { return __hip_atomic_load(p, __ATOMIC_RELAXED, __HIP_MEMORY_SCOPE_AGENT); }
__device__ __forceinline__ unsigned xb_add(unsigned* p, unsigned v) { return __hip_atomic_fetch_add(p, v, __ATOMIC_RELAXED, __HIP_MEMORY_SCOPE_AGENT); }
__device__ __forceinline__ unsigned xb_xcc_id() { return (unsigned)__builtin_amdgcn_s_getreg((3 << 11) | 20) & 0xFu; }
#define XB_SPIN(cond, bar) do { unsigned _sp = 0; while (cond) { __builtin_amdgcn_s_sleep(1); \
    if ((++_sp & 255u) == 0u) { if (xb_ld(&(bar)[XB_TMO])) break; if (_sp > XB_SPIN_CAP) { atomicAdd(&(bar)[XB_TMO], 1u); break; } } } } while (0)

struct XcdBarrier {
    unsigned* bar; unsigned x;
    volatile LAS unsigned* st;
};

__device__ __forceinline__ XcdBarrier xcd_barrier_post(unsigned* bar, volatile LAS unsigned* st) {
    XcdBarrier b; b.bar = bar; b.x = xb_xcc_id(); b.st = st;
    if (threadIdx.x == 0) (void)xb_add(&bar[XB_XCNT(b.x)], 1u);
    return b;
}
__device__ __forceinline__ void xcd_barrier_complete(unsigned* bar, unsigned x, unsigned& nloc, unsigned& nx) {
    const unsigned G = gridDim.x * gridDim.y * gridDim.z;
    unsigned sum, cnt, mine, sp = 0u;
    for (;;) {
        sum = 0u; cnt = 0u; mine = 0u;
#pragma unroll
        for (unsigned j = 0; j < 16; ++j) { const unsigned c = xb_ld(&bar[XB_XCNT(j)]); sum += c; cnt += (c > 0u) ? 1u : 0u; mine = (j == x) ? c : mine; }
        if (sum == G) break;
        __builtin_amdgcn_s_sleep(1);
        if ((++sp & 255u) == 0u) { if (xb_ld(&bar[XB_TMO])) break; if (sp > XB_SPIN_CAP) { atomicAdd(&bar[XB_TMO], 1u); break; } }
    }
    nloc = mine > 0u ? mine : 1u; nx = cnt > 0u ? cnt : 1u;
}

__device__ __forceinline__ void xcd_barrier(const XcdBarrier& b) {
    asm volatile("s_waitcnt vmcnt(0)" ::: "memory");
    __syncthreads();
    if (threadIdx.x == 0) {
        unsigned* bar = b.bar;
        __builtin_amdgcn_s_waitcnt(0);
        unsigned nloc = b.st[0], nx = b.st[1];
        if (nloc == 0u) { xcd_barrier_complete(bar, b.x, nloc, nx); b.st[0] = nloc; b.st[1] = nx; }
        const unsigned old = xb_add(&bar[XB_XSUB(b.x)], 1u);
        const unsigned gen = old / nloc;
        if (old + 1u == (gen + 1u) * nloc) {
            __builtin_amdgcn_fence(__ATOMIC_RELEASE, "agent");
            asm volatile("s_waitcnt vmcnt(0)" ::: "memory");
            const unsigned og = xb_add(&bar[XB_TOP], 1u);
            const unsigned tg = og / nx;
            if (og + 1u == (tg + 1u) * nx) xb_add(&bar[XB_TOPGEN], 1u);
            else XB_SPIN(xb_ld(&bar[XB_TOPGEN]) == tg, bar);
            __builtin_amdgcn_fence(__ATOMIC_ACQUIRE, "agent");
            xb_add(&bar[XB_XGEN(b.x)], 1u);
            asm volatile("s_waitcnt vmcnt(0)" ::: "memory");
        } else {
            XB_SPIN(xb_ld(&bar[XB_XGEN(b.x)]) == gen, bar);
            __builtin_amdgcn_fence(__ATOMIC_ACQUIRE, "agent");
            asm volatile("s_waitcnt vmcnt(0)" ::: "memory");
        }
    }
    __syncthreads();
}
constexpr int NWAVES = 8, NTHREADS = 512;
constexpr int DM = 1024, M_CTX = 8192, M_LAT = 4096, M_ALL = 12288, L_CTX = 256, L_LAT = 1024, D_IN = 10240, NH = 16, HD = 64;
constexpr float LN_EPS = 1e-5f, ALPHA = 1.189207115002721f, LOG2E = 1.4426950408889634f, C2 = 0.125f * LOG2E;
constexpr float MIN_DECAY = -3.0701134573253945f, MAX_DECAY = -15.350567286626973f;
constexpr size_t MiB = 1u << 20;
constexpr size_t PLANE_E = (size_t)M_ALL * DM;
constexpr size_t WS_CTL = 0, CTL_ZERO_BYTES = 1 * MiB;
constexpr size_t WS_MOD = 1 * MiB;
constexpr size_t WS_WIN = 2 * MiB, WS_WBH = 22 * MiB, WS_WBA = 24 * MiB, WS_WOUT = 26 * MiB;
constexpr size_t WS_RTC = 28 * MiB, WS_RTL = 29 * MiB;
constexpr size_t WS_CK = 34 * MiB, WS_CV = 36 * MiB;
constexpr size_t WS_XN = 38 * MiB;
constexpr size_t WS_PL = 62 * MiB;
constexpr size_t WS_END = 254 * MiB;
constexpr int CW_BAR = 4096;
constexpr int N_PHASES = 9;
constexpr int RING_BYTES = 131072, LDSCTL_OFF = RING_BYTES, MISC_OFF = LDSCTL_OFF + 320, LDS_BYTES = 147456;

__device__ __forceinline__ float bf2f(bf16 v) { return __uint_as_float((unsigned)v << 16); }
__device__ __forceinline__ float sigm(float x) { return __builtin_amdgcn_rcpf(1.0f + __builtin_amdgcn_exp2f(-LOG2E * x)); }
__device__ __forceinline__ float wave_sum(float v) {
#pragma unroll
    for (int o = 1; o < 64; o <<= 1) v += __shfl_xor(v, o);
    return v;
}
__device__ __forceinline__ float wave_max(float v) {
#pragma unroll
    for (int o = 1; o < 64; o <<= 1) v = fmaxf(v, __shfl_xor(v, o));
    return v;
}

struct Args { const float* in[24]; float* out; unsigned char* ws; int ph_lo, ph_hi, li, pad; };
enum { I_XP = 0, I_XS, I_C, I_CK, I_CV, I_CCTX, I_WADA, I_BADA, I_WIN, I_CONVW, I_CONVB, I_FW1, I_FB1, I_FW2, I_FB2, I_FW3, I_FFREQ, I_HD, I_RPB, I_WBH, I_WBA, I_WOUT, I_LNG, I_LNB };

__device__ __forceinline__ void p0_transpose_item(const float* W, int K, int N, bf16* WT, LAS float* scr, int item, int lane) {
    const int nblk = N / 32, kb = item / nblk, nb = item % nblk, k0 = 64 * kb, n0 = 32 * nb;
#pragma unroll 8
    for (int i = 0; i < 32; ++i) { const int kk = 2 * i + (lane >> 5); scr[kk * 33 + (lane & 31)] = W[(size_t)(k0 + kk) * N + n0 + (lane & 31)]; }
    LDS_WAIT(); asm volatile("" ::: "memory");
    const int c = lane & 7;
#pragma unroll
    for (int j = 0; j < 4; ++j) { const int n = (lane >> 3) + 8 * j; const LAS float* s = scr + (8 * c) * 33 + n;
        v4u o; o.x = pk2(s[0 * 33], s[1 * 33]); o.y = pk2(s[2 * 33], s[3 * 33]); o.z = pk2(s[4 * 33], s[5 * 33]); o.w = pk2(s[6 * 33], s[7 * 33]);
        *(GAS v4u*)(WT + (size_t)(n0 + n) * K + k0 + 8 * c) = o; }
    LDS_WAIT(); asm volatile("" ::: "memory");
}

__device__ __forceinline__ void phase_prologue(const Args& A, LAS unsigned char* lds) {
    const int tid = threadIdx.x, lane = tid & 63, wave = __builtin_amdgcn_readfirstlane(tid >> 6);
    const int G = gridDim.x, bid = blockIdx.x;
    unsigned char* ws = A.ws;
    for (int task = bid; task < 48; task += G) {
        LAS float* sc = (LAS float*)lds;
        LAS float* red = (LAS float*)(lds + 20480);
        const float* c_ctx = A.in[I_CCTX]; const float* c = A.in[I_C]; const float* w_ada = A.in[I_WADA]; const float* b_ada = A.in[I_BADA];
        float* mod = (float*)(ws + WS_MOD);
        for (int idx = tid; idx < 5 * 1024; idx += NTHREADS) { const int i = idx >> 10, k = idx & 1023; const float v = (i == 0) ? c_ctx[k] : c[(i - 1) * 1024 + k]; sc[idx] = v * sigm(v); }
        __syncthreads();
        const int col = task * 64 + lane;
        float a0 = 0.f, a1 = 0.f, a2 = 0.f, a3 = 0.f, a4 = 0.f;
        const float* wp = w_ada + (size_t)(wave * 128) * 3072 + col;
#pragma unroll 8
        for (int k = 0; k < 128; ++k) { const float w = wp[(size_t)k * 3072]; const int kk = wave * 128 + k;
            a0 += sc[kk] * w; a1 += sc[1024 + kk] * w; a2 += sc[2048 + kk] * w; a3 += sc[3072 + kk] * w; a4 += sc[4096 + kk] * w; }
        red[(wave * 5 + 0) * 64 + lane] = a0; red[(wave * 5 + 1) * 64 + lane] = a1; red[(wave * 5 + 2) * 64 + lane] = a2; red[(wave * 5 + 3) * 64 + lane] = a3; red[(wave * 5 + 4) * 64 + lane] = a4;
        __syncthreads();
        if (tid < 320) { const int i = tid >> 6, l = tid & 63; float s = b_ada[task * 64 + l];
#pragma unroll
            for (int w = 0; w < 8; ++w) s += red[(w * 5 + i) * 64 + l];
            mod[i * 3072 + task * 64 + l] = s; }
        __syncthreads();
    }
    for (int task = G - 1 - bid; task < 160; task += G) {
        if (task < 0) break;
        const int grp = task < 32 ? 0 : 1, L = grp ? L_LAT : L_CTX, i0 = (grp ? task - 32 : task) * 8;
        LAS float* zl = (LAS float*)lds; LAS float* h1l = zl + 512; LAS float* h2l = h1l + 512;
        const float* w1 = A.in[I_FW1]; const float* b1 = A.in[I_FB1]; const float* w2 = A.in[I_FW2]; const float* b2 = A.in[I_FB2]; const float* w3 = A.in[I_FW3]; const float* fq = A.in[I_FFREQ]; const float* hd = A.in[I_HD];
        {
            const int i = i0 + wave;
            const float tpos = (float)i / (float)(L - 1), w = 6.283185307179586f * (float)i / (float)L;
            float zv = 0.f;
            if (lane == 0) zv = tpos;
            else if (lane <= 16) { const float band = 1e-4f + (float)(lane - 1) * ((15.0f - 1e-4f) / 15.0f); zv = cosf(band * w); }
            else if (lane <= 32) { const float band = 1e-4f + (float)(lane - 17) * ((15.0f - 1e-4f) / 15.0f); zv = -sinf(band * w); }
            zl[wave * 64 + lane] = zv;
            LDS_WAIT(); asm volatile("" ::: "memory");
            float a = b1[lane];
#pragma unroll
            for (int e = 0; e < 33; ++e) a += zl[wave * 64 + e] * w1[e * 64 + lane];
            h1l[wave * 64 + lane] = sinf(fq[lane] * a);
            LDS_WAIT(); asm volatile("" ::: "memory");
            a = b2[lane];
#pragma unroll 8
            for (int e = 0; e < 64; ++e) a += h1l[wave * 64 + e] * w2[e * 64 + lane];
            h2l[wave * 64 + lane] = sinf(fq[64 + lane] * a);
        }
        __syncthreads();
        float acc[8][4];
#pragma unroll
        for (int p = 0; p < 8; ++p)
#pragma unroll
            for (int m = 0; m < 4; ++m) acc[p][m] = 0.f;
        for (int k = 0; k < 64; ++k) {
            float wv[4];
#pragma unroll
            for (int m = 0; m < 4; ++m) wv[m] = w3[(size_t)k * 2048 + tid + 512 * m];
#pragma unroll
            for (int p = 0; p < 8; ++p) { const float hv = h2l[p * 64 + k];
#pragma unroll
                for (int m = 0; m < 4; ++m) acc[p][m] += hv * wv[m]; }
        }
        bf16* RT = (bf16*)(ws + (grp ? WS_RTL : WS_RTC)); const int R2L = 2 * L;
#pragma unroll
        for (int m = 0; m < 4; ++m) { const int j = tid + 512 * m, dir = j >> 10, c = j & 1023;
            const float ad = fabsf(MIN_DECAY + (float)c * ((MAX_DECAY - MIN_DECAY) / 1023.0f));
#pragma unroll
            for (int p = 0; p < 8; ++p) { const int ii = i0 + p; const float tpos = (float)ii / (float)(L - 1);
                float val = acc[p][m] * (__expf(-tpos * ad) + 0.05f);
                if (dir == 0) { if (ii == 0) val += hd[c]; RT[(size_t)c * R2L + (L - 1 - ii)] = (bf16)f2bf(val); }
                else { if (ii == 0) RT[(size_t)c * R2L + R2L - 1] = (bf16)0; else RT[(size_t)c * R2L + (L - 1 + ii)] = (bf16)f2bf(val); } } }
        __syncthreads();
    }
    {
        LAS float* scr = (LAS float*)(lds + wave * 16384);
        const int gw = bid * NWAVES + wave, NGW = G * NWAVES;
        constexpr int I_BIG = 16 * 320, I_SM = 16 * 32, NIT = I_BIG + 3 * I_SM;
        for (int it = gw; it < NIT; it += NGW) {
            int r = it;
            if (r < I_BIG) { p0_transpose_item(A.in[I_WIN], 1024, D_IN, (bf16*)(ws + WS_WIN), scr, r, lane); continue; } r -= I_BIG;
            if (r < I_SM) { p0_transpose_item(A.in[I_WBH], 1024, 1024, (bf16*)(ws + WS_WBH), scr, r, lane); continue; } r -= I_SM;
            if (r < I_SM) { p0_transpose_item(A.in[I_WBA], 1024, 1024, (bf16*)(ws + WS_WBA), scr, r, lane); continue; } r -= I_SM;
            p0_transpose_item(A.in[I_WOUT], 1024, 1024, (bf16*)(ws + WS_WOUT), scr, r, lane);
        }
        for (int rr = gw; rr < 2048; rr += NGW) {
            const float* src = (rr < 1024 ? A.in[I_CK] : A.in[I_CV]) + (size_t)(rr & 1023) * 1024;
            bf16* dst = (bf16*)(ws + (rr < 1024 ? WS_CK : WS_CV)) + (size_t)(rr & 1023) * 1024;
#pragma unroll
            for (int j = 0; j < 4; ++j) { const f32x4 v = *(const f32x4*)(src + 256 * j + 4 * lane);
                *(unsigned long long*)(dst + 256 * j + 4 * lane) = (unsigned long long)pk2(v.x, v.y) | ((unsigned long long)pk2(v.z, v.w) << 32); }
        }
    }
}

__device__ __forceinline__ void phase_xn(const Args& A) {
    const int tid = threadIdx.x, lane = tid & 63, wave = __builtin_amdgcn_readfirstlane(tid >> 6);
    const int gw = blockIdx.x * NWAVES + wave, NGW = gridDim.x * NWAVES;
    const float* mod = (const float*)(A.ws + WS_MOD); bf16* XN = (bf16*)(A.ws + WS_XN);
    for (int row = gw; row < M_ALL; row += NGW) {
        const int cond = row < M_CTX ? 0 : 1 + ((row - M_CTX) >> 10);
        const float* x = row < M_CTX ? A.in[I_XP] + (size_t)row * DM : A.in[I_XS] + (size_t)(row - M_CTX) * DM;
        const float* sh = mod + cond * 3072; const float* scl = sh + 1024;
#pragma unroll
        for (int j = 0; j < 4; ++j) { const int o = 256 * j + 4 * lane; const f32x4 v = *(const f32x4*)(x + o), s = *(const f32x4*)(scl + o), b = *(const f32x4*)(sh + o);
            const f32x4 h = v * (s + 1.0f) + b;
            *(unsigned long long*)(XN + (size_t)row * DM + o) = (unsigned long long)pk2(h.x, h.y) | ((unsigned long long)pk2(h.z, h.w) << 32); }
    }
}

__device__ __forceinline__ void phase_hyena_u(const Args& A) {
    const bf16* VH = (const bf16*)(A.ws + WS_PL); const bf16* X1 = VH + PLANE_E; bf16* U = (bf16*)(A.ws + WS_XN);
    const float* cw = A.in[I_CONVW]; const float* cb = A.in[I_CONVB];
    const size_t total = (size_t)128 * M_ALL;
    for (size_t idx = (size_t)blockIdx.x * NTHREADS + threadIdx.x; idx < total; idx += (size_t)gridDim.x * NTHREADS) {
        const int q = (int)(idx / M_ALL), row = (int)(idx % M_ALL);
        int s, L; if (row < M_CTX) { s = row & 255; L = L_CTX; } else { s = (row - M_CTX) & 1023; L = L_LAT; }
        const bool hp = s > 0, hn = s < L - 1;
        float uv[8];
#pragma unroll
        for (int pl = 0; pl < 2; ++pl) {
            const bf16* P = (pl ? X1 : VH) + idx * 8;
            const v4u z = {0u, 0u, 0u, 0u};
            const v4u a0 = hp ? *(const v4u*)(P - 8) : z, a1 = *(const v4u*)P, a2 = hn ? *(const v4u*)(P + 8) : z;
            const unsigned w0[4] = {a0.x, a0.y, a0.z, a0.w}, w1[4] = {a1.x, a1.y, a1.z, a1.w}, w2[4] = {a2.x, a2.y, a2.z, a2.w};
#pragma unroll
            for (int e = 0; e < 8; ++e) { const int col = pl * 1024 + q * 8 + e;
                const float x0 = (e & 1) ? __uint_as_float(w0[e >> 1] & 0xffff0000u) : __uint_as_float(w0[e >> 1] << 16);
                const float x1 = (e & 1) ? __uint_as_float(w1[e >> 1] & 0xffff0000u) : __uint_as_float(w1[e >> 1] << 16);
                const float x2 = (e & 1) ? __uint_as_float(w2[e >> 1] & 0xffff0000u) : __uint_as_float(w2[e >> 1] << 16);
                const float r = cw[col] * x0 + cw[3072 + col] * x1 + cw[6144 + col] * x2 + cb[col];
                uv[e] = pl ? uv[e] * r : r; }
        }
        v4u o; o.x = pk2(uv[0], uv[1]); o.y = pk2(uv[2], uv[3]); o.z = pk2(uv[4], uv[5]); o.w = pk2(uv[6], uv[7]);
        *(v4u*)(U + idx * 8) = o;
    }
}
__device__ __forceinline__ void phase_hyena_conv_naive(const Args& A) {
    const int tid = threadIdx.x, lane = tid & 63, wave = __builtin_amdgcn_readfirstlane(tid >> 6);
    const int gw = blockIdx.x * NWAVES + wave, NGW = gridDim.x * NWAVES;
    const bf16* U = (const bf16*)(A.ws + WS_XN); bf16* PL = (bf16*)(A.ws + WS_PL);
    const bf16* X0 = PL + 2 * PLANE_E; const bf16* GH = PL + 3 * PLANE_E; bf16* HG = PL;
    const float* cw = A.in[I_CONVW]; const float* cb = A.in[I_CONVB];
    for (int task = gw; task < 196608; task += NGW) {
        int tb, b, c, L, rowbase;
        if (task < 131072) { tb = task & 3; b = (task >> 2) & 31; c = task >> 7; L = L_CTX; rowbase = b * 256; }
        else { const int t2 = task - 131072; tb = t2 & 15; b = (t2 >> 4) & 3; c = t2 >> 6; L = L_LAT; rowbase = M_CTX + b * 1024; }
        const int t = tb * 64 + lane;
        const bf16* R = (const bf16*)(A.ws + (L == L_LAT ? WS_RTL : WS_RTC)) + (size_t)c * 2 * L + (L - 1 - t);
        const size_t cbase = ((size_t)(c >> 3) * M_ALL + rowbase) * 8 + (c & 7);
        const bf16* Ub = U + cbase;
        float acc = 0.f;
        for (int s0 = 0; s0 < L; s0 += 64) {
            const float ureg = bf2f(Ub[(size_t)(s0 + lane) * 8]);
#pragma unroll
            for (int j = 0; j < 64; ++j) acc += __uint_as_float(__builtin_amdgcn_readlane(__float_as_uint(ureg), j)) * bf2f(R[s0 + j]);
        }
        const bf16* X0b = X0 + cbase; const bf16* GHb = GH + cbase;
        const float xm = t > 0 ? bf2f(X0b[(size_t)(t - 1) * 8]) : 0.f, xc = bf2f(X0b[(size_t)t * 8]), xp = t < L - 1 ? bf2f(X0b[(size_t)(t + 1) * 8]) : 0.f;
        const float x0c = cw[2048 + c] * xm + cw[3072 + 2048 + c] * xc + cw[6144 + 2048 + c] * xp + cb[2048 + c];
        const float sg = bf2f(GHb[(size_t)t * 8]);
        HG[(size_t)(rowbase + t) * DM + c] = (bf16)f2bf(acc * x0c * sg);
    }
}
__device__ __forceinline__ float dot64(const float (&q)[64], const bf16* k) {
    float s = 0.f;
#pragma unroll
    for (int i = 0; i < 8; ++i) { const v4u w = *(const v4u*)(k + 8 * i);
        s += q[8 * i + 0] * __uint_as_float(w.x << 16) + q[8 * i + 1] * __uint_as_float(w.x & 0xffff0000u) + q[8 * i + 2] * __uint_as_float(w.y << 16) + q[8 * i + 3] * __uint_as_float(w.y & 0xffff0000u)
           + q[8 * i + 4] * __uint_as_float(w.z << 16) + q[8 * i + 5] * __uint_as_float(w.z & 0xffff0000u) + q[8 * i + 6] * __uint_as_float(w.w << 16) + q[8 * i + 7] * __uint_as_float(w.w & 0xffff0000u); }
    return s;
}
__device__ __forceinline__ void phase_attn_naive(const Args& A) {
    const int tid = threadIdx.x, lane = tid & 63, wave = __builtin_amdgcn_readfirstlane(tid >> 6);
    const int gw = blockIdx.x * NWAVES + wave, NGW = gridDim.x * NWAVES;
    bf16* PL = (bf16*)(A.ws + WS_PL);
    bf16* Q = PL + 4 * PLANE_E; const bf16* K = PL + 5 * PLANE_E; const bf16* V = PL + 6 * PLANE_E; const bf16* GA = PL + 7 * PLANE_E;
    const bf16* CK = (const bf16*)(A.ws + WS_CK); const bf16* CV = (const bf16*)(A.ws + WS_CV);
    const float* rpb = A.in[I_RPB];
    for (int task = gw; task < M_ALL * NH; task += NGW) {
        const int row = task >> 4, h = task & 15;
        float q[64];
        { const bf16* qp = Q + (size_t)row * DM + h * HD;
#pragma unroll
          for (int i = 0; i < 8; ++i) { const v4u w = *(const v4u*)(qp + 8 * i);
              q[8 * i + 0] = __uint_as_float(w.x << 16); q[8 * i + 1] = __uint_as_float(w.x & 0xffff0000u); q[8 * i + 2] = __uint_as_float(w.y << 16); q[8 * i + 3] = __uint_as_float(w.y & 0xffff0000u);
              q[8 * i + 4] = __uint_as_float(w.z << 16); q[8 * i + 5] = __uint_as_float(w.z & 0xffff0000u); q[8 * i + 6] = __uint_as_float(w.w << 16); q[8 * i + 7] = __uint_as_float(w.w & 0xffff0000u); } }
        float sc[6]; int vrow[6];
        const bool lat = row >= M_CTX;
        if (!lat) { const int b = row >> 8;
#pragma unroll
            for (int j = 0; j < 4; ++j) { vrow[j] = b * 256 + j * 64 + lane; sc[j] = dot64(q, K + (size_t)vrow[j] * DM + h * HD); }
            sc[4] = -INFINITY; sc[5] = -INFINITY; vrow[4] = 0; vrow[5] = 0;
        } else { const int rl = row - M_CTX, b = rl >> 10, pos = rl & 1023, gr = pos >> 6, gc = pos & 63;
            const int r0 = min(max(gr - 4, 0), 8), c0 = min(max(gc - 8, 0), 48);
#pragma unroll
            for (int j = 0; j < 2; ++j) { const int kr = r0 + j * 4 + (lane >> 4), kc = c0 + (lane & 15); vrow[j] = M_CTX + b * 1024 + kr * 64 + kc;
                const float bias = rpb[(h * 15 + (kr - gr + 7)) * 31 + (kc - gc + 15)] * LOG2E;
                sc[j] = dot64(q, K + (size_t)vrow[j] * DM + h * HD) + bias; }
#pragma unroll
            for (int j = 0; j < 4; ++j) { vrow[2 + j] = b * 256 + j * 64 + lane; sc[2 + j] = dot64(q, CK + (size_t)vrow[2 + j] * DM + h * HD); }
        }
        float m = sc[0];
#pragma unroll
        for (int j = 1; j < 6; ++j) m = fmaxf(m, sc[j]);
        m = wave_max(m);
        float l = 0.f;
#pragma unroll
        for (int j = 0; j < 6; ++j) { sc[j] = __builtin_amdgcn_exp2f(sc[j] - m); l += sc[j]; }
        l = wave_sum(l);
        float o = 0.f;
#pragma unroll
        for (int j = 0; j < 6; ++j) {
            if (!lat && j >= 4) continue;
            const bf16* Vb = (lat && j >= 2) ? CV : V;
            for (int kk = 0; kk < 64; ++kk) { const float pk = __shfl(sc[j], kk); const int vr = __shfl(vrow[j], kk);
                o += pk * bf2f(Vb[(size_t)vr * DM + h * HD + lane]); }
        }
        const size_t oo = (size_t)row * DM + h * HD + lane;
        Q[oo] = (bf16)f2bf(o / l * bf2f(GA[oo]));
    }
}

__device__ __forceinline__ void phase_ln(const Args& A) {
    const int tid = threadIdx.x, lane = tid & 63, wave = __builtin_amdgcn_readfirstlane(tid >> 6);
    const int gw = blockIdx.x * NWAVES + wave, NGW = gridDim.x * NWAVES;
    const float* g = A.in[I_LNG]; const float* be = A.in[I_LNB];
    for (int row = gw; row < M_ALL; row += NGW) {
        float* y = A.out + (size_t)row * DM;
        f32x4 v[4]; float s = 0.f;
#pragma unroll
        for (int j = 0; j < 4; ++j) { v[j] = *(const f32x4*)(y + 256 * j + 4 * lane); s += (v[j].x + v[j].y) + (v[j].z + v[j].w); }
        const float mean = wave_sum(s) * (1.f / DM); float s2 = 0.f;
#pragma unroll
        for (int j = 0; j < 4; ++j) { v[j] = v[j] - mean; s2 += (v[j].x * v[j].x + v[j].y * v[j].y) + (v[j].z * v[j].z + v[j].w * v[j].w); }
        const float rstd = 1.f / sqrtf(wave_sum(s2) * (1.f / DM) + LN_EPS);
#pragma unroll
        for (int j = 0; j < 4; ++j) { const f32x4 gg = *(const f32x4*)(g + 256 * j + 4 * lane), bb = *(const f32x4*)(be + 256 * j + 4 * lane);
            *(f32x4*)(y + 256 * j + 4 * lane) = v[j] * rstd * gg + bb; }
    }
}

__global__ void __launch_bounds__(NWAVES * 64, 2) fwd_kernel(Args args) {
    extern __shared__ __attribute__((aligned(16))) unsigned char lds_raw[];
    LAS unsigned char* lds = (LAS unsigned char*)lds_raw;
    const int tid = threadIdx.x;
    for (int u = tid; u < (LDS_BYTES - LDSCTL_OFF) / 4; u += NWAVES * 64) ((LAS unsigned*)(lds + LDSCTL_OFF))[u] = 0u;
    __syncthreads();
    const int lo = args.ph_lo, hi = args.ph_hi;
    const bool use_bar = (hi - lo) > 1;
    gu32* ctl = (gu32*)(args.ws + WS_CTL);
    XcdBarrier bar; bar.bar = (unsigned*)(ctl + CW_BAR) + args.li * XCD_BAR_WORDS; bar.x = 0; bar.st = nullptr;
    if (use_bar) bar = xcd_barrier_post((unsigned*)(ctl + CW_BAR) + args.li * XCD_BAR_WORDS, (volatile LAS unsigned*)(lds + MISC_OFF) + 8);
#define IN(k) (lo <= (k) && (k) < hi)
#define SEAM(k) do { if (IN(k) && IN((k) + 1)) xcd_barrier(bar); } while (0)
    bf16* PL = (bf16*)(args.ws + WS_PL);
    if (IN(0)) { phase_prologue(args, lds); SEAM(0); }
    if (IN(1)) { phase_xn(args); SEAM(1); }
    if (IN(2)) {
        pg8::Gemm g{(const bf16*)(args.ws + WS_XN), (const bf16*)(args.ws + WS_WIN), M_ALL, D_IN, DM}; pg8::StaticOrder S; S.init(M_ALL, D_IN, gridDim.x, (int)blockIdx.x);
        pg8::EpiProj E{PL, (bf16*)args.out, args.out + (size_t)M_ALL * DM, args.out + (size_t)M_ALL * DM + (size_t)M_CTX * DM, C2};
        pg8::gemm_phase<pg8::EpiProj, pg8::StaticOrder, true, true>(lds, g, S, E);
        SEAM(2);
    }
    if (IN(3)) { phase_hyena_u(args); SEAM(3); }
    if (IN(4)) { phase_hyena_conv_naive(args); phase_attn_naive(args); SEAM(4); }
    if (IN(5)) {
        pg8::Gemm g{PL, (const bf16*)(args.ws + WS_WBH), M_ALL, DM, DM}; pg8::StaticOrder S; S.init(M_ALL, DM, gridDim.x, (int)blockIdx.x);
        pg8::EpiGate E{(const bf16*)args.out, nullptr, PL + PLANE_E};
        pg8::gemm_phase<pg8::EpiGate, pg8::StaticOrder, true, true>(lds, g, S, E);
        SEAM(5);
    }
    if (IN(6)) {
        pg8::Gemm g{PL + 4 * PLANE_E, (const bf16*)(args.ws + WS_WBA), M_ALL, DM, DM}; pg8::StaticOrder S; S.init(M_ALL, DM, gridDim.x, (int)blockIdx.x);
        pg8::EpiGate E{(const bf16*)args.out + PLANE_E, PL + PLANE_E, PL + 2 * PLANE_E};
        pg8::gemm_phase<pg8::EpiGate, pg8::StaticOrder, true, true>(lds, g, S, E);
        SEAM(6);
    }
    if (IN(7)) {
        pg8::Gemm g{PL + 2 * PLANE_E, (const bf16*)(args.ws + WS_WOUT), M_ALL, DM, DM}; pg8::StaticOrder S; S.init(M_ALL, DM, gridDim.x, (int)blockIdx.x);
        pg8::EpiResid E{args.in[I_XP], args.in[I_XS], (const float*)(args.ws + WS_MOD), args.out, ALPHA};
        pg8::gemm_phase<pg8::EpiResid, pg8::StaticOrder, true, true>(lds, g, S, E);
        SEAM(7);
    }
    if (IN(8)) { phase_ln(args); }
#undef IN
#undef SEAM
}

#ifndef N_LAUNCH_MODE
#define N_LAUNCH_MODE 1
#endif
extern "C" void kernel_launch(void* const* d_in, const int* in_sizes, int n_in, void* d_out, int out_size, void* d_ws, size_t ws_size, hipStream_t stream) {
    static int grid = 0;
    if (grid == 0) {
        if (n_in != 24 || ws_size < WS_END) { fprintf(stderr, "kernel_launch: unexpected n_in %d / ws_size %zu\n", n_in, ws_size); grid = -1; return; }
        int dev = 0, cus = 0, per_cu = 0;
        if (hipGetDevice(&dev) != hipSuccess || hipDeviceGetAttribute(&cus, hipDeviceAttributeMultiprocessorCount, dev) != hipSuccess) { grid = -1; return; }
        if (hipFuncSetAttribute((const void*)fwd_kernel, hipFuncAttributeMaxDynamicSharedMemorySize, LDS_BYTES) != hipSuccess) { fprintf(stderr, "kernel_launch: hipFuncSetAttribute failed\n"); grid = -1; return; }
        if (hipOccupancyMaxActiveBlocksPerMultiprocessor(&per_cu, (const void*)fwd_kernel, NWAVES * 64, LDS_BYTES) != hipSuccess || per_cu < 1) { fprintf(stderr, "kernel_launch: occupancy query says %d blocks per CU\n", per_cu); per_cu = 1; }
        (void)hipGetLastError();
        grid = cus;
    }
    if (grid < 0) return;
    (void)hipMemsetAsync((char*)d_ws + WS_CTL, 0, CTL_ZERO_BYTES, stream);
    Args a{};
    for (int i = 0; i < 24; ++i) a.in[i] = (const float*)d_in[i];
    a.out = (float*)d_out; a.ws = (unsigned char*)d_ws;
    if (N_LAUNCH_MODE == 1) {
        a.ph_lo = 0; a.ph_hi = N_PHASES; a.li = 0;
        hipLaunchKernelGGL(fwd_kernel, dim3(grid), dim3(NWAVES * 64), LDS_BYTES, stream, a);
    } else {
        for (int p = 0; p < N_PHASES; ++p) { a.ph_lo = p; a.ph_hi = p + 1; a.li = 0;
            hipLaunchKernelGGL(fwd_kernel, dim3(grid), dim3(NWAVES * 64), LDS_BYTES, stream, a); }
    }
}
```

```cpp
#include <hip/hip_runtime.h>
#include <cstdio>
#include <cstdint>
#include <cmath>
namespace pg8 {
#define PG8_LAS __attribute__((address_space(3)))
typedef unsigned short bf16_t;
typedef short bf16x8 __attribute__((ext_vector_type(8)));
typedef float f32x4 __attribute__((ext_vector_type(4)));
typedef unsigned u32x4 __attribute__((ext_vector_type(4)));
constexpr int BM = 256, BK = 64, HALF = 128, HTB = HALF * BK * 2  , STAGE_BYTES = 8 * HTB, NXCD = 8, WGM = 8;

__host__ __device__ __forceinline__ int lds_byte(int r, int c) { const int st = (r >> 4) * 2 + (c >> 5), rr = r & 15, cc = c & 31, ob = rr * 64 + cc * 2; return st * 1024 + (ob ^ (((ob >> 9) & 1) << 5)); }
__host__ __device__ __forceinline__ void stage_rc(int b, int& R, int& C) { const int st = b / 1024, sb = b % 1024, swz = sb ^ (((sb >> 9) & 1) << 5); R = (st >> 1) * 16 + swz / 64; C = (st & 1) * 32 + (swz % 64) / 2; }
__host__ __device__ __forceinline__ int perm32(int rho) { const int n = rho >> 4, i = rho & 15; return 8 * (i >> 2) + 4 * n + (i & 3); }

struct Unit { int pm, pn; };
struct Gemm { const bf16_t* A; const bf16_t* Bt; int M, N, K; };

struct StaticOrder {
    int nM, nN, nwg, G, c;
    __host__ __device__ void init(int M, int N, int G_, int c_) { nM = M / BM; nN = N / BM; nwg = nM * nN; G = G_; c = c_; }
    __host__ __device__ bool next(int i, Unit& u) const {
        const long L = (long)i * G + c; if (L >= nwg) return false;
        int wgid = (int)L; { const int q = nwg / NXCD, r = nwg % NXCD, xcd = wgid % NXCD, off = wgid / NXCD; wgid = (xcd < r ? xcd * (q + 1) : r * (q + 1) + (xcd - r) * q) + off; }
        const int nig = WGM * nN, gid = wgid / nig, fm = gid * WGM, gsz = (nM - fm) < WGM ? (nM - fm) : WGM;
        u.pm = fm + ((wgid % nig) % gsz); u.pn = (wgid % nig) / gsz; return true;
    }
    __device__ __forceinline__ void a_ready(const Unit&) const {}
    __device__ __forceinline__ void done(const Unit&) const {}
};

__device__ __forceinline__ unsigned cvt_pk_bf16(float lo, float hi) { unsigned r; asm volatile("v_cvt_pk_bf16_f32 %0, %1, %2" : "=v"(r) : "v"(lo), "v"(hi)); return r; }
typedef float f32x2 __attribute__((ext_vector_type(2)));
__device__ __forceinline__ f32x2 gelu_pk(f32x2 v) {
    const f32x2 av = __builtin_elementwise_abs(v), d = av * 0.2316418882f + 1.0f;
    f32x2 t; t.x = __builtin_amdgcn_rcpf(d.x); t.y = __builtin_amdgcn_rcpf(d.y);
    f32x2 q = t * 0.5307027145f + (-0.7265760135f); q = q * t + 0.7107068705f; q = q * t + (-0.142248368f); q = q * t + 0.127414796f; q = q * t;
    const f32x2 s = (v * v) * (-0.72134752044f);
    f32x2 e; e.x = __builtin_amdgcn_exp2f(s.x); e.y = __builtin_amdgcn_exp2f(s.y);
    const f32x2 m = v * (q * e), r = v - m;
    f32x2 o; o.x = v.x < 0.f ? m.x : r.x; o.y = v.y < 0.f ? m.y : r.y; return o;
}

typedef unsigned u32x2e __attribute__((ext_vector_type(2)));
__device__ __forceinline__ float sigmoid_f(float x) { return __builtin_amdgcn_rcpf(1.0f + __builtin_amdgcn_exp2f(-1.4426950408889634f * x)); }
constexpr int EP_M = 12288;
constexpr size_t EP_PLANE = (size_t)EP_M * 1024;
struct EpiProj {
    static constexpr bool PERM = true, AFTER_DRAIN = false;
    bf16_t* planes;
    bf16_t* mplanes;
    float* newk; float* newv;
    float qscale;
    __device__ __forceinline__ void operator()(const f32x4 (&acc)[2][2][4][2], const Unit& u, int wr, int wc, int fr, int fq) const {
        const int t = u.pn >> 2;
        const int row0 = u.pm * BM + wr * 64 + fr, colp0 = (u.pn & 3) * BM + wc * 32 + 8 * fq;
        bf16_t* base = (t < 8) ? planes + (size_t)t * EP_PLANE : mplanes + (size_t)(t - 8) * EP_PLANE;
        const bool chunk = t < 4;
        const int mode = (t == 3 || t == 7) ? 1 : (t >= 8 ? 2 : (t == 4 ? 3 : 0));
        float* f32o = (u.pm < 32) ? (t == 5 ? newk : (t == 6 ? newv : nullptr)) : nullptr;
#pragma unroll
        for (int ai = 0; ai < 2; ++ai)
#pragma unroll
            for (int m = 0; m < 4; ++m) { const int row = row0 + ai * HALF + m * 16;
#pragma unroll
                for (int bj = 0; bj < 2; ++bj) { const int col = colp0 + bj * HALF;
                    f32x4 v0 = acc[ai][bj][m][0], v1 = acc[ai][bj][m][1];
                    if (f32o) { float* p = f32o + (size_t)row * 1024 + col; *(f32x4*)p = v0; *(f32x4*)(p + 4) = v1; }
                    if (mode == 1) {
#pragma unroll
                        for (int e = 0; e < 4; ++e) { v0[e] = v0[e] * sigmoid_f(v0[e]); v1[e] = v1[e] * sigmoid_f(v1[e]); }
                    } else if (mode == 2) {
#pragma unroll
                        for (int e = 0; e < 4; ++e) { v0[e] = sigmoid_f(v0[e]); v1[e] = sigmoid_f(v1[e]); }
                    } else if (mode == 3) { v0 = v0 * qscale; v1 = v1 * qscale; }
                    u32x4 w; w.x = cvt_pk_bf16(v0[0], v0[1]); w.y = cvt_pk_bf16(v0[2], v0[3]); w.z = cvt_pk_bf16(v1[0], v1[1]); w.w = cvt_pk_bf16(v1[2], v1[3]);
                    bf16_t* dst = chunk ? base + ((size_t)(col >> 3) * EP_M + row) * 8 : base + (size_t)row * 1024 + col;
                    *(u32x4*)dst = w; } }
    }
};
__device__ __forceinline__ float bf_lo(unsigned w) { return __uint_as_float(w << 16); }
__device__ __forceinline__ float bf_hi(unsigned w) { return __uint_as_float(w & 0xffff0000u); }
struct EpiGate {
    static constexpr bool PERM = true, AFTER_DRAIN = false;
    const bf16_t* gate; const bf16_t* prev; bf16_t* O;
    __device__ __forceinline__ void operator()(const f32x4 (&acc)[2][2][4][2], const Unit& u, int wr, int wc, int fr, int fq) const {
        const int row0 = u.pm * BM + wr * 64 + fr, col0 = u.pn * BM + wc * 32 + 8 * fq;
#pragma unroll
        for (int ai = 0; ai < 2; ++ai)
#pragma unroll
            for (int m = 0; m < 4; ++m) { const size_t ro = (size_t)(row0 + ai * HALF + m * 16) * 1024 + col0;
#pragma unroll
                for (int bj = 0; bj < 2; ++bj) { const size_t o = ro + bj * HALF;
                    const u32x4 g = *(const u32x4*)(gate + o);
                    f32x4 v0 = acc[ai][bj][m][0], v1 = acc[ai][bj][m][1];
                    v0[0] *= bf_lo(g.x); v0[1] *= bf_hi(g.x); v0[2] *= bf_lo(g.y); v0[3] *= bf_hi(g.y);
                    v1[0] *= bf_lo(g.z); v1[1] *= bf_hi(g.z); v1[2] *= bf_lo(g.w); v1[3] *= bf_hi(g.w);
                    if (prev) { const u32x4 p = *(const u32x4*)(prev + o);
                        v0[0] += bf_lo(p.x); v0[1] += bf_hi(p.x); v0[2] += bf_lo(p.y); v0[3] += bf_hi(p.y);
                        v1[0] += bf_lo(p.z); v1[1] += bf_hi(p.z); v1[2] += bf_lo(p.w); v1[3] += bf_hi(p.w); }
                    u32x4 w; w.x = cvt_pk_bf16(v0[0], v0[1]); w.y = cvt_pk_bf16(v0[2], v0[3]); w.z = cvt_pk_bf16(v1[0], v1[1]); w.w = cvt_pk_bf16(v1[2], v1[3]);
                    *(u32x4*)(O + o) = w; } }
    }
};
struct EpiResid {
    static constexpr bool PERM = true, AFTER_DRAIN = false;
    const float* xp; const float* xs; const float* mod; float* V; float alpha;
    __device__ __forceinline__ void operator()(const f32x4 (&acc)[2][2][4][2], const Unit& u, int wr, int wc, int fr, int fq) const {
        const int row0 = u.pm * BM + wr * 64 + fr, col0 = u.pn * BM + wc * 32 + 8 * fq;
        const int cond = (u.pm < 32) ? 0 : 1 + ((u.pm - 32) >> 2);
        const float* x = (u.pm < 32) ? xp : xs - (size_t)8192 * 1024;
        f32x4 g[2][2];
#pragma unroll
        for (int bj = 0; bj < 2; ++bj) { g[bj][0] = *(const f32x4*)(mod + cond * 3072 + 2048 + col0 + bj * HALF); g[bj][1] = *(const f32x4*)(mod + cond * 3072 + 2048 + col0 + bj * HALF + 4); }
#pragma unroll
        for (int ai = 0; ai < 2; ++ai)
#pragma unroll
            for (int m = 0; m < 4; ++m) { const size_t ro = (size_t)(row0 + ai * HALF + m * 16) * 1024 + col0;
#pragma unroll
                for (int bj = 0; bj < 2; ++bj) { const size_t o = ro + bj * HALF;
                    const f32x4 x0 = *(const f32x4*)(x + o), x1 = *(const f32x4*)(x + o + 4);
                    *(f32x4*)(V + o) = x0 * alpha + g[bj][0] * acc[ai][bj][m][0];
                    *(f32x4*)(V + o + 4) = x1 * alpha + g[bj][1] * acc[ai][bj][m][1]; } }
    }
};
template <class Epi, class Sched, bool ALIGN_EPI = false, bool SP2 = false>
__device__ __forceinline__ void gemm_phase(PG8_LAS unsigned char* lds, const Gemm g, const Sched& S, const Epi& E) {
    const int tid = threadIdx.x, wid = __builtin_amdgcn_readfirstlane(tid >> 6), lane = tid & 63, wr = wid >> 2, wc = wid & 3, fr = lane & 15, fq = lane >> 4;
    const int K = g.K, nt = K / BK;
    unsigned voffA[2], voffB[2];
#pragma unroll
    for (int i = 0; i < 2; ++i) { int R, C; stage_rc(tid * 16 + i * 8192, R, C); const int Rb = Epi::PERM ? ((R & ~31) + perm32(R & 31)) : R;
        voffA[i] = (unsigned)(R * K + C) * 2u; voffB[i] = (unsigned)(Rb * K + C) * 2u; }
    const size_t kstep = (size_t)(BK * 2);
    const size_t hstep = (size_t)HALF * K * 2;
    const size_t tstep = 2 * hstep;
    const unsigned ldsw = (unsigned)wid * 1024u;
    const int aoff = lds_byte(wr * 64 + fr, fq * 8), boff = lds_byte(wc * 32 + fr, fq * 8);
#define PG8_SA(b, h) (((b) * 2 + (h)) * HTB)
#define PG8_SB(b, h) ((4 + (b) * 2 + (h)) * HTB)
#define PG8_STAGE(bufoff, gbase, voff) do { _Pragma("unroll") for (int _i = 0; _i < 2; ++_i) \
        __builtin_amdgcn_global_load_lds((const unsigned*)((const char*)(gbase) + (voff)[_i]), (PG8_LAS unsigned*)(lds + (bufoff) + ldsw + _i * 8192), 16, 0, 0); } while (0)
#define PG8_LDA(dst, b, h) do { _Pragma("unroll") for (int m = 0; m < 4; ++m) _Pragma("unroll") for (int k = 0; k < 2; ++k) dst[m][k] = *(const PG8_LAS bf16x8*)(lds + PG8_SA(b, h) + aoff + m * 2048 + k * 1024); } while (0)
#define PG8_LDB(dst, b, h) do { _Pragma("unroll") for (int n = 0; n < 2; ++n) _Pragma("unroll") for (int k = 0; k < 2; ++k) dst[n][k] = *(const PG8_LAS bf16x8*)(lds + PG8_SB(b, h) + boff + n * 2048 + k * 1024); } while (0)
#define PG8_MMA(ai, bj, At, Bt) do { __builtin_amdgcn_s_setprio(1); _Pragma("unroll") for (int m = 0; m < 4; ++m) _Pragma("unroll") for (int n = 0; n < 2; ++n) _Pragma("unroll") for (int k = 0; k < 2; ++k) \
        acc[ai][bj][m][n] = __builtin_amdgcn_mfma_f32_16x16x32_bf16(Bt[n][k], At[m][k], acc[ai][bj][m][n], 0, 0, 0); __builtin_amdgcn_s_setprio(0); } while (0)
#define PG8_WAIT_V(n) asm volatile("s_waitcnt vmcnt(" #n ")" ::: "memory")
#define PG8_WAIT_L(n) asm volatile("s_waitcnt lgkmcnt(" #n ")" ::: "memory")
#define PG8_BAR __builtin_amdgcn_s_barrier()
#define PG8_SCHED __builtin_amdgcn_sched_barrier(0)
    Unit cur, nxt; int ui = 0;
    if (!S.next(0, cur)) return;
    f32x4 acc[2][2][4][2];
#pragma unroll
    for (int a = 0; a < 2; ++a)
#pragma unroll
        for (int b = 0; b < 2; ++b)
#pragma unroll
            for (int m = 0; m < 4; ++m)
#pragma unroll
                for (int n = 0; n < 2; ++n) acc[a][b][m][n] = (f32x4){0.f, 0.f, 0.f, 0.f};
    bf16x8 At[4][2], B0[2][2], B1[2][2];
    const char* cA = (const char*)g.A + (size_t)cur.pm * tstep; const char* cB = (const char*)g.Bt + (size_t)cur.pn * tstep;
    S.a_ready(cur);
    if constexpr (SP2) {
        PG8_STAGE(PG8_SB(0, 0), cB, voffB); PG8_STAGE(PG8_SB(0, 1), cB + hstep, voffB); PG8_STAGE(PG8_SA(0, 0), cA, voffA); PG8_STAGE(PG8_SA(0, 1), cA + hstep, voffA);
        if (wr == 1) PG8_BAR;
        PG8_WAIT_V(2); PG8_BAR;
        PG8_STAGE(PG8_SB(1, 0), cB + kstep, voffB); PG8_STAGE(PG8_SA(1, 0), cA + kstep, voffA); PG8_STAGE(PG8_SB(1, 1), cB + hstep + kstep, voffB);
        PG8_WAIT_V(6); PG8_BAR;
    } else {
        PG8_STAGE(PG8_SB(0, 0), cB, voffB); PG8_STAGE(PG8_SA(0, 0), cA, voffA); PG8_STAGE(PG8_SB(0, 1), cB + hstep, voffB); PG8_STAGE(PG8_SA(0, 1), cA + hstep, voffA);
        if (wr == 1) PG8_BAR;
        PG8_WAIT_V(4); PG8_BAR;
        PG8_STAGE(PG8_SB(1, 0), cB + kstep, voffB); PG8_STAGE(PG8_SA(1, 0), cA + kstep, voffA); PG8_STAGE(PG8_SB(1, 1), cB + hstep + kstep, voffB);
        PG8_WAIT_V(6); PG8_BAR;
    }
    for (;;) {
        const bool has_next = S.next(ui + 1, nxt);
        const char* nA = has_next ? (const char*)g.A + (size_t)nxt.pm * tstep : cA; const char* nB = has_next ? (const char*)g.Bt + (size_t)nxt.pn * tstep : cB;
        for (int t = 0; t < nt; t += 2) {
            const bool last = (t == nt - 2);
            const char* a1 = cA + (size_t)(t + 1) * kstep;
            const char* a2 = last ? nA : cA + (size_t)(t + 2) * kstep; const char* b2 = last ? nB : cB + (size_t)(t + 2) * kstep;
            const char* a3 = a2 + kstep; const char* b3 = b2 + kstep;
            if (last && has_next) S.a_ready(nxt);
            if constexpr (SP2) {
            PG8_LDB(B0, 0, 0); PG8_LDB(B1, 0, 1); PG8_SCHED; PG8_LDA(At, 0, 0); PG8_STAGE(PG8_SA(1, 1), a1 + hstep, voffA);
            PG8_WAIT_V(8); PG8_WAIT_L(0); PG8_BAR; PG8_MMA(0, 0, At, B0); PG8_MMA(0, 1, At, B1); PG8_BAR; PG8_SCHED;
            PG8_LDA(At, 0, 1); PG8_STAGE(PG8_SB(0, 0), b2, voffB); PG8_STAGE(PG8_SB(0, 1), b2 + hstep, voffB); PG8_STAGE(PG8_SA(0, 0), a2, voffA);
            PG8_WAIT_V(8); PG8_WAIT_L(0); PG8_BAR; PG8_MMA(1, 0, At, B0); PG8_MMA(1, 1, At, B1); PG8_BAR; PG8_SCHED;
            PG8_LDB(B0, 1, 0); PG8_LDB(B1, 1, 1); PG8_SCHED; PG8_LDA(At, 1, 0); PG8_STAGE(PG8_SA(0, 1), a2 + hstep, voffA);
            PG8_WAIT_V(8); PG8_WAIT_L(0); PG8_BAR; PG8_MMA(0, 0, At, B0); PG8_MMA(0, 1, At, B1); PG8_BAR; PG8_SCHED;
            PG8_LDA(At, 1, 1); PG8_STAGE(PG8_SB(1, 0), b3, voffB); PG8_STAGE(PG8_SB(1, 1), b3 + hstep, voffB); PG8_STAGE(PG8_SA(1, 0), a3, voffA);
            PG8_WAIT_V(8); PG8_WAIT_L(0); PG8_BAR; PG8_MMA(1, 0, At, B0); PG8_MMA(1, 1, At, B1); PG8_BAR; PG8_SCHED;
            } else {
            PG8_LDB(B0, 0, 0); PG8_SCHED; PG8_LDA(At, 0, 0); PG8_STAGE(PG8_SA(1, 1), a1 + hstep, voffA);
            PG8_WAIT_L(8); PG8_BAR; PG8_WAIT_L(0); PG8_MMA(0, 0, At, B0); PG8_BAR; PG8_SCHED;
            PG8_LDB(B1, 0, 1); PG8_STAGE(PG8_SB(0, 0), b2, voffB);
            PG8_BAR; PG8_WAIT_L(0); PG8_MMA(0, 1, At, B1); PG8_BAR;
            PG8_LDA(At, 0, 1); PG8_STAGE(PG8_SA(0, 0), a2, voffA);
            PG8_BAR; PG8_WAIT_L(0); PG8_MMA(1, 0, At, B0); PG8_BAR; PG8_SCHED;
            PG8_STAGE(PG8_SB(0, 1), b2 + hstep, voffB);
            PG8_WAIT_V(6); PG8_BAR; PG8_MMA(1, 1, At, B1); PG8_BAR;
            PG8_LDB(B0, 1, 0); PG8_SCHED; PG8_LDA(At, 1, 0); PG8_STAGE(PG8_SA(0, 1), a2 + hstep, voffA);
            PG8_WAIT_L(8); PG8_BAR; PG8_WAIT_L(0); PG8_MMA(0, 0, At, B0); PG8_BAR; PG8_SCHED;
            PG8_LDB(B1, 1, 1); PG8_STAGE(PG8_SB(1, 0), b3, voffB);
            PG8_BAR; PG8_WAIT_L(0); PG8_MMA(0, 1, At, B1); PG8_BAR;
            PG8_LDA(At, 1, 1); PG8_STAGE(PG8_SA(1, 0), a3, voffA);
            PG8_BAR; PG8_WAIT_L(0); PG8_MMA(1, 0, At, B0); PG8_BAR; PG8_SCHED;
            PG8_STAGE(PG8_SB(1, 1), b3 + hstep, voffB);
            PG8_WAIT_V(6); PG8_BAR; PG8_MMA(1, 1, At, B1); PG8_BAR;
            }
        }
        if constexpr (ALIGN_EPI) { if (wr == 0) PG8_BAR; }
        if constexpr (!Epi::AFTER_DRAIN) { E(acc, cur, wr, wc, fr, fq); S.done(cur); }
        if (!has_next) break;
#pragma unroll
        for (int a = 0; a < 2; ++a)
#pragma unroll
            for (int b = 0; b < 2; ++b)
#pragma unroll
                for (int m = 0; m < 4; ++m)
#pragma unroll
                    for (int n = 0; n < 2; ++n) acc[a][b][m][n] = (f32x4){0.f, 0.f, 0.f, 0.f};
        cur = nxt; cA = nA; cB = nB; ++ui;
        if constexpr (ALIGN_EPI) { if (wr == 1) PG8_BAR; }
    }
    PG8_WAIT_V(0);
    if constexpr (!ALIGN_EPI) { if (wr == 0) PG8_BAR; }
    PG8_BAR;
    if constexpr (Epi::AFTER_DRAIN) { E.fused(acc, cur, wr, wc, fr, fq, lds, wid, lane); S.done(cur); }
#undef PG8_SA
#undef PG8_SB
#undef PG8_STAGE
#undef PG8_LDA
#undef PG8_LDB
#undef PG8_MMA
#undef PG8_WAIT_V
#undef PG8_WAIT_L
#undef PG8_BAR
#undef PG8_SCHED
}
}
#define GAS __attribute__((address_space(1)))
#define LAS __attribute__((address_space(3)))
typedef unsigned short bf16;
typedef unsigned v4u __attribute__((ext_vector_type(4)));
typedef float f32x4 __attribute__((ext_vector_type(4)));
typedef short bf16x8 __attribute__((ext_vector_type(8)));
typedef GAS unsigned gu32;
typedef GAS unsigned long long gu64;
#define RLX_AGENT __ATOMIC_RELAXED, __HIP_MEMORY_SCOPE_AGENT
#define LDS_WAIT() asm volatile("s_waitcnt lgkmcnt(0)" ::: "memory")
#define VM_WAIT() asm volatile("s_waitcnt vmcnt(0)" ::: "memory")
__device__ __forceinline__ unsigned long long rt() { return __builtin_amdgcn_s_memrealtime(); }
__device__ __forceinline__ unsigned f2bf(float f) { unsigned u = __builtin_bit_cast(unsigned, f); return (u + 0x7fffu + ((u >> 16) & 1u)) >> 16; }
__device__ __forceinline__ unsigned pk2(float lo, float hi) { return f2bf(lo) | (f2bf(hi) << 16); }

#define XB_TMO      128
#define XB_XCNT(j)  (256  + 64 * (j))
#define XB_XSUB(j)  (1280 + 64 * (j))
#define XB_XGEN(j)  (2304 + 64 * (j))
#define XB_TOP      3328
#define XB_TOPGEN   3392
#define XCD_BAR_WORDS 3456
#define XB_SPIN_CAP (1u << 18)

__device__ __forceinline__ unsigned xb_ld(unsigned* p)              { return __hip_atomic_load(p, __ATOMIC_RELAXED, __HIP_MEMORY_SCOPE_AGENT); }
__device__ __forceinline__ unsigned xb_add(unsigned* p, unsigned v) { return __hip_atomic_fetch_add(p, v, __ATOMIC_RELAXED, __HIP_MEMORY_SCOPE_AGENT); }
__device__ __forceinline__ unsigned xb_xcc_id() { return (unsigned)__builtin_amdgcn_s_getreg((3 << 11) | 20) & 0xFu; }
#define XB_SPIN(cond, bar) do { unsigned _sp = 0; while (cond) { __builtin_amdgcn_s_sleep(1); \
    if ((++_sp & 255u) == 0u) { if (xb_ld(&(bar)[XB_TMO])) break; if (_sp > XB_SPIN_CAP) { atomicAdd(&(bar)[XB_TMO], 1u); break; } } } } while (0)

struct XcdBarrier {
    unsigned* bar; unsigned x;
    volatile LAS unsigned* st;
};

__device__ __forceinline__ XcdBarrier xcd_barrier_post(unsigned* bar, volatile LAS unsigned* st) {
    XcdBarrier b; b.bar = bar; b.x = xb_xcc_id(); b.st = st;
    if (threadIdx.x == 0) (void)xb_add(&bar[XB_XCNT(b.x)], 1u);
    return b;
}
__device__ __forceinline__ void xcd_barrier_complete(unsigned* bar, unsigned x, unsigned& nloc, unsigned& nx) {
    const unsigned G = gridDim.x * gridDim.y * gridDim.z;
    unsigned sum, cnt, mine, sp = 0u;
    for (;;) {
        sum = 0u; cnt = 0u; mine = 0u;
#pragma unroll
        for (unsigned j = 0; j < 16; ++j) { const unsigned c = xb_ld(&bar[XB_XCNT(j)]); sum += c; cnt += (c > 0u) ? 1u : 0u; mine = (j == x) ? c : mine; }
        if (sum == G) break;
        __builtin_amdgcn_s_sleep(1);
        if ((++sp & 255u) == 0u) { if (xb_ld(&bar[XB_TMO])) break; if (sp > XB_SPIN_CAP) { atomicAdd(&bar[XB_TMO], 1u); break; } }
    }
    nloc = mine > 0u ? mine : 1u; nx = cnt > 0u ? cnt : 1u;
}

__device__ __forceinline__ void xcd_barrier(const XcdBarrier& b) {
    asm volatile("s_waitcnt vmcnt(0)" ::: "memory");
    __syncthreads();
    if (threadIdx.x == 0) {
        unsigned* bar = b.bar;
        __builtin_amdgcn_s_waitcnt(0);
        unsigned nloc = b.st[0], nx = b.st[1];
        if (nloc == 0u) { xcd_barrier_complete(bar, b.x, nloc, nx); b.st[0] = nloc; b.st[1] = nx; }
        const unsigned old = xb_add(&bar[XB_XSUB(b.x)], 1u);
        const unsigned gen = old / nloc;
        if (old + 1u == (gen + 1u) * nloc) {
            __builtin_amdgcn_fence(__ATOMIC_RELEASE, "agent");
            asm volatile("s_waitcnt vmcnt(0)" ::: "memory");
            const unsigned og = xb_add(&bar[XB_TOP], 1u);
            const unsigned tg = og / nx;
            if (og + 1u == (tg + 1u) * nx) xb_add(&bar[XB_TOPGEN], 1u);
            else XB_SPIN(xb_ld(&bar[XB_TOPGEN]) == tg, bar);
            __builtin_amdgcn_fence(__ATOMIC_ACQUIRE, "agent");
            xb_add(&bar[XB_XGEN(b.x)], 1u);
            asm volatile("s_waitcnt vmcnt(0)" ::: "memory");
        } else {
            XB_SPIN(xb_ld(&bar[XB_XGEN(b.x)]) == gen, bar);
            __builtin_amdgcn_fence(__ATOMIC_ACQUIRE, "agent");
            asm volatile("s_waitcnt vmcnt(0)" ::: "memory");
        }
    }
    __syncthreads();
}
constexpr int NWAVES = 8, NTHREADS = 512;
constexpr int DM = 1024, M_CTX = 8192, M_LAT = 4096, M_ALL = 12288, L_CTX = 256, L_LAT = 1024, D_IN = 10240, NH = 16, HD = 64;
constexpr float LN_EPS = 1e-5f, ALPHA = 1.189207115002721f, LOG2E = 1.4426950408889634f, C2 = 0.125f * LOG2E;
constexpr float MIN_DECAY = -3.0701134573253945f, MAX_DECAY = -15.350567286626973f;
constexpr size_t MiB = 1u << 20;
constexpr size_t PLANE_E = (size_t)M_ALL * DM;
constexpr size_t WS_CTL = 0, CTL_ZERO_BYTES = 1 * MiB;
constexpr size_t WS_MOD = 1 * MiB;
constexpr size_t WS_WIN = 2 * MiB, WS_WBH = 22 * MiB, WS_WBA = 24 * MiB, WS_WOUT = 26 * MiB;
constexpr size_t WS_RTC = 28 * MiB, WS_RTL = 29 * MiB;
constexpr size_t WS_CK = 34 * MiB, WS_CV = 36 * MiB;
constexpr size_t WS_XN = 38 * MiB;
constexpr size_t WS_PL = 62 * MiB;
constexpr size_t WS_END = 254 * MiB;
constexpr int CW_BAR = 4096;
constexpr int N_PHASES = 9;
constexpr int RING_BYTES = 131072, LDSCTL_OFF = RING_BYTES, MISC_OFF = LDSCTL_OFF + 320, LDS_BYTES = 147456;

__device__ __forceinline__ float bf2f(bf16 v) { return __uint_as_float((unsigned)v << 16); }
__device__ __forceinline__ float sigm(float x) { return __builtin_amdgcn_rcpf(1.0f + __builtin_amdgcn_exp2f(-LOG2E * x)); }
__device__ __forceinline__ float wave_sum(float v) {
#pragma unroll
    for (int o = 1; o < 64; o <<= 1) v += __shfl_xor(v, o);
    return v;
}
__device__ __forceinline__ float wave_max(float v) {
#pragma unroll
    for (int o = 1; o < 64; o <<= 1) v = fmaxf(v, __shfl_xor(v, o));
    return v;
}

struct Args { const float* in[24]; float* out; unsigned char* ws; int ph_lo, ph_hi, li, pad; };
enum { I_XP = 0, I_XS, I_C, I_CK, I_CV, I_CCTX, I_WADA, I_BADA, I_WIN, I_CONVW, I_CONVB, I_FW1, I_FB1, I_FW2, I_FB2, I_FW3, I_FFREQ, I_HD, I_RPB, I_WBH, I_WBA, I_WOUT, I_LNG, I_LNB };

__device__ __forceinline__ void p0_transpose_item(const float* W, int K, int N, bf16* WT, LAS float* scr, int item, int lane) {
    const int nblk = N / 32, kb = item / nblk, nb = item % nblk, k0 = 64 * kb, n0 = 32 * nb;
#pragma unroll 8
    for (int i = 0; i < 32; ++i) { const int kk = 2 * i + (lane >> 5); scr[kk * 33 + (lane & 31)] = W[(size_t)(k0 + kk) * N + n0 + (lane & 31)]; }
    LDS_WAIT(); asm volatile("" ::: "memory");
    const int c = lane & 7;
#pragma unroll
    for (int j = 0; j < 4; ++j) { const int n = (lane >> 3) + 8 * j; const LAS float* s = scr + (8 * c) * 33 + n;
        v4u o; o.x = pk2(s[0 * 33], s[1 * 33]); o.y = pk2(s[2 * 33], s[3 * 33]); o.z = pk2(s[4 * 33], s[5 * 33]); o.w = pk2(s[6 * 33], s[7 * 33]);
        *(GAS v4u*)(WT + (size_t)(n0 + n) * K + k0 + 8 * c) = o; }
    LDS_WAIT(); asm volatile("" ::: "memory");
}

__device__ __forceinline__ void phase_prologue(const Args& A, LAS unsigned char* lds) {
    const int tid = threadIdx.x, lane = tid & 63, wave = __builtin_amdgcn_readfirstlane(tid >> 6);
    const int G = gridDim.x, bid = blockIdx.x;
    unsigned char* ws = A.ws;
    for (int task = bid; task < 48; task += G) {
        LAS float* sc = (LAS float*)lds;
        LAS float* red = (LAS float*)(lds + 20480);
        const float* c_ctx = A.in[I_CCTX]; const float* c = A.in[I_C]; const float* w_ada = A.in[I_WADA]; const float* b_ada = A.in[I_BADA];
        float* mod = (float*)(ws + WS_MOD);
        for (int idx = tid; idx < 5 * 1024; idx += NTHREADS) { const int i = idx >> 10, k = idx & 1023; const float v = (i == 0) ? c_ctx[k] : c[(i - 1) * 1024 + k]; sc[idx] = v * sigm(v); }
        __syncthreads();
        const int col = task * 64 + lane;
        float a0 = 0.f, a1 = 0.f, a2 = 0.f, a3 = 0.f, a4 = 0.f;
        const float* wp = w_ada + (size_t)(wave * 128) * 3072 + col;
#pragma unroll 8
        for (int k = 0; k < 128; ++k) { const float w = wp[(size_t)k * 3072]; const int kk = wave * 128 + k;
            a0 += sc[kk] * w; a1 += sc[1024 + kk] * w; a2 += sc[2048 + kk] * w; a3 += sc[3072 + kk] * w; a4 += sc[4096 + kk] * w; }
        red[(wave * 5 + 0) * 64 + lane] = a0; red[(wave * 5 + 1) * 64 + lane] = a1; red[(wave * 5 + 2) * 64 + lane] = a2; red[(wave * 5 + 3) * 64 + lane] = a3; red[(wave * 5 + 4) * 64 + lane] = a4;
        __syncthreads();
        if (tid < 320) { const int i = tid >> 6, l = tid & 63; float s = b_ada[task * 64 + l];
#pragma unroll
            for (int w = 0; w < 8; ++w) s += red[(w * 5 + i) * 64 + l];
            mod[i * 3072 + task * 64 + l] = s; }
        __syncthreads();
    }
    for (int task = G - 1 - bid; task < 160; task += G) {
        if (task < 0) break;
        const int grp = task < 32 ? 0 : 1, L = grp ? L_LAT : L_CTX, i0 = (grp ? task - 32 : task) * 8;
        LAS float* zl = (LAS float*)lds; LAS float* h1l = zl + 512; LAS float* h2l = h1l + 512;
        const float* w1 = A.in[I_FW1]; const float* b1 = A.in[I_FB1]; const float* w2 = A.in[I_FW2]; const float* b2 = A.in[I_FB2]; const float* w3 = A.in[I_FW3]; const float* fq = A.in[I_FFREQ]; const float* hd = A.in[I_HD];
        {
            const int i = i0 + wave;
            const float tpos = (float)i / (float)(L - 1), w = 6.283185307179586f * (float)i / (float)L;
            float zv = 0.f;
            if (lane == 0) zv = tpos;
            else if (lane <= 16) { const float band = 1e-4f + (float)(lane - 1) * ((15.0f - 1e-4f) / 15.0f); zv = cosf(band * w); }
            else if (lane <= 32) { const float band = 1e-4f + (float)(lane - 17) * ((15.0f - 1e-4f) / 15.0f); zv = -sinf(band * w); }
            zl[wave * 64 + lane] = zv;
            LDS_WAIT(); asm volatile("" ::: "memory");
            float a = b1[lane];
#pragma unroll
            for (int e = 0; e < 33; ++e) a += zl[wave * 64 + e] * w1[e * 64 + lane];
            h1l[wave * 64 + lane] = sinf(fq[lane] * a);
            LDS_WAIT(); asm volatile("" ::: "memory");
            a = b2[lane];
#pragma unroll 8
            for (int e = 0; e < 64; ++e) a += h1l[wave * 64 + e] * w2[e * 64 + lane];
            h2l[wave * 64 + lane] = sinf(fq[64 + lane] * a);
        }
        __syncthreads();
        float acc[8][4];
#pragma unroll
        for (int p = 0; p < 8; ++p)
#pragma unroll
            for (int m = 0; m < 4; ++m) acc[p][m] = 0.f;
        for (int k = 0; k < 64; ++k) {
            float wv[4];
#pragma unroll
            for (int m = 0; m < 4; ++m) wv[m] = w3[(size_t)k * 2048 + tid + 512 * m];
#pragma unroll
            for (int p = 0; p < 8; ++p) { const float hv = h2l[p * 64 + k];
#pragma unroll
                for (int m = 0; m < 4; ++m) acc[p][m] += hv * wv[m]; }
        }
        bf16* RT = (bf16*)(ws + (grp ? WS_RTL : WS_RTC)); const int R2L = 2 * L;
#pragma unroll
        for (int m = 0; m < 4; ++m) { const int j = tid + 512 * m, dir = j >> 10, c = j & 1023;
            const float ad = fabsf(MIN_DECAY + (float)c * ((MAX_DECAY - MIN_DECAY) / 1023.0f));
#pragma unroll
            for (int p = 0; p < 8; ++p) { const int ii = i0 + p; const float tpos = (float)ii / (float)(L - 1);
                float val = acc[p][m] * (__expf(-tpos * ad) + 0.05f);
                if (dir == 0) { if (ii == 0) val += hd[c]; RT[(size_t)c * R2L + (L - 1 - ii)] = (bf16)f2bf(val); }
                else { if (ii == 0) RT[(size_t)c * R2L + R2L - 1] = (bf16)0; else RT[(size_t)c * R2L + (L - 1 + ii)] = (bf16)f2bf(val); } } }
        __syncthreads();
    }
    {
        LAS float* scr = (LAS float*)(lds + wave * 16384);
        const int gw = bid * NWAVES + wave, NGW = G * NWAVES;
        constexpr int I_BIG = 16 * 320, I_SM = 16 * 32, NIT = I_BIG + 3 * I_SM;
        for (int it = gw; it < NIT; it += NGW) {
            int r = it;
            if (r < I_BIG) { p0_transpose_item(A.in[I_WIN], 1024, D_IN, (bf16*)(ws + WS_WIN), scr, r, lane); continue; } r -= I_BIG;
            if (r < I_SM) { p0_transpose_item(A.in[I_WBH], 1024, 1024, (bf16*)(ws + WS_WBH), scr, r, lane); continue; } r -= I_SM;
            if (r < I_SM) { p0_transpose_item(A.in[I_WBA], 1024, 1024, (bf16*)(ws + WS_WBA), scr, r, lane); continue; } r -= I_SM;
            p0_transpose_item(A.in[I_WOUT], 1024, 1024, (bf16*)(ws + WS_WOUT), scr, r, lane);
        }
        for (int rr = gw; rr < 2048; rr += NGW) {
            const float* src = (rr < 1024 ? A.in[I_CK] : A.in[I_CV]) + (size_t)(rr & 1023) * 1024;
            bf16* dst = (bf16*)(ws + (rr < 1024 ? WS_CK : WS_CV)) + (size_t)(rr & 1023) * 1024;
#pragma unroll
            for (int j = 0; j < 4; ++j) { const f32x4 v = *(const f32x4*)(src + 256 * j + 4 * lane);
                *(unsigned long long*)(dst + 256 * j + 4 * lane) = (unsigned long long)pk2(v.x, v.y) | ((unsigned long long)pk2(v.z, v.w) << 32); }
        }
    }
}

__device__ __forceinline__ void phase_xn(const Args& A) {
    const int tid = threadIdx.x, lane = tid & 63, wave = __builtin_amdgcn_readfirstlane(tid >> 6);
    const int gw = blockIdx.x * NWAVES + wave, NGW = gridDim.x * NWAVES;
    const float* mod = (const float*)(A.ws + WS_MOD); bf16* XN = (bf16*)(A.ws + WS_XN);
    for (int row = gw; row < M_ALL; row += NGW) {
        const int cond = row < M_CTX ? 0 : 1 + ((row - M_CTX) >> 10);
        const float* x = row < M_CTX ? A.in[I_XP] + (size_t)row * DM : A.in[I_XS] + (size_t)(row - M_CTX) * DM;
        const float* sh = mod + cond * 3072; const float* scl = sh + 1024;
#pragma unroll
        for (int j = 0; j < 4; ++j) { const int o = 256 * j + 4 * lane; const f32x4 v = *(const f32x4*)(x + o), s = *(const f32x4*)(scl + o), b = *(const f32x4*)(sh + o);
            const f32x4 h = v * (s + 1.0f) + b;
            *(unsigned long long*)(XN + (size_t)row * DM + o) = (unsigned long long)pk2(h.x, h.y) | ((unsigned long long)pk2(h.z, h.w) << 32); }
    }
}

__device__ __forceinline__ void phase_hyena_u(const Args& A) {
    const bf16* VH = (const bf16*)(A.ws + WS_PL); const bf16* X1 = VH + PLANE_E; bf16* U = (bf16*)(A.ws + WS_XN);
    const float* cw = A.in[I_CONVW]; const float* cb = A.in[I_CONVB];
    const size_t total = (size_t)128 * M_ALL;
    for (size_t idx = (size_t)blockIdx.x * NTHREADS + threadIdx.x; idx < total; idx += (size_t)gridDim.x * NTHREADS) {
        const int q = (int)(idx / M_ALL), row = (int)(idx % M_ALL);
        int s, L; if (row < M_CTX) { s = row & 255; L = L_CTX; } else { s = (row - M_CTX) & 1023; L = L_LAT; }
        const bool hp = s > 0, hn = s < L - 1;
        float uv[8];
#pragma unroll
        for (int pl = 0; pl < 2; ++pl) {
            const bf16* P = (pl ? X1 : VH) + idx * 8;
            const v4u z = {0u, 0u, 0u, 0u};
            const v4u a0 = hp ? *(const v4u*)(P - 8) : z, a1 = *(const v4u*)P, a2 = hn ? *(const v4u*)(P + 8) : z;
            const unsigned w0[4] = {a0.x, a0.y, a0.z, a0.w}, w1[4] = {a1.x, a1.y, a1.z, a1.w}, w2[4] = {a2.x, a2.y, a2.z, a2.w};
#pragma unroll
            for (int e = 0; e < 8; ++e) { const int col = pl * 1024 + q * 8 + e;
                const float x0 = (e & 1) ? __uint_as_float(w0[e >> 1] & 0xffff0000u) : __uint_as_float(w0[e >> 1] << 16);
                const float x1 = (e & 1) ? __uint_as_float(w1[e >> 1] & 0xffff0000u) : __uint_as_float(w1[e >> 1] << 16);
                const float x2 = (e & 1) ? __uint_as_float(w2[e >> 1] & 0xffff0000u) : __uint_as_float(w2[e >> 1] << 16);
                const float r = cw[col] * x0 + cw[3072 + col] * x1 + cw[6144 + col] * x2 + cb[col];
                uv[e] = pl ? uv[e] * r : r; }
        }
        v4u o; o.x = pk2(uv[0], uv[1]); o.y = pk2(uv[2], uv[3]); o.z = pk2(uv[4], uv[5]); o.w = pk2(uv[6], uv[7]);
        *(v4u*)(U + idx * 8) = o;
    }
}
__device__ __forceinline__ void phase_hyena_conv_naive(const Args& A) {
    const int tid = threadIdx.x, lane = tid & 63, wave = __builtin_amdgcn_readfirstlane(tid >> 6);
    const int gw = blockIdx.x * NWAVES + wave, NGW = gridDim.x * NWAVES;
    const bf16* U = (const bf16*)(A.ws + WS_XN); bf16* PL = (bf16*)(A.ws + WS_PL);
    const bf16* X0 = PL + 2 * PLANE_E; const bf16* GH = PL + 3 * PLANE_E; bf16* HG = PL;
    const float* cw = A.in[I_CONVW]; const float* cb = A.in[I_CONVB];
    for (int task = gw; task < 196608; task += NGW) {
        int tb, b, c, L, rowbase;
        if (task < 131072) { tb = task & 3; b = (task >> 2) & 31; c = task >> 7; L = L_CTX; rowbase = b * 256; }
        else { const int t2 = task - 131072; tb = t2 & 15; b = (t2 >> 4) & 3; c = t2 >> 6; L = L_LAT; rowbase = M_CTX + b * 1024; }
        const int t = tb * 64 + lane;
        const bf16* R = (const bf16*)(A.ws + (L == L_LAT ? WS_RTL : WS_RTC)) + (size_t)c * 2 * L + (L - 1 - t);
        const size_t cbase = ((size_t)(c >> 3) * M_ALL + rowbase) * 8 + (c & 7);
        const bf16* Ub = U + cbase;
        float acc = 0.f;
        for (int s0 = 0; s0 < L; s0 += 64) {
            const float ureg = bf2f(Ub[(size_t)(s0 + lane) * 8]);
#pragma unroll
            for (int j = 0; j < 64; ++j) acc += __uint_as_float(__builtin_amdgcn_readlane(__float_as_uint(ureg), j)) * bf2f(R[s0 + j]);
        }
        const bf16* X0b = X0 + cbase; const bf16* GHb = GH + cbase;
        const float xm = t > 0 ? bf2f(X0b[(size_t)(t - 1) * 8]) : 0.f, xc = bf2f(X0b[(size_t)t * 8]), xp = t < L - 1 ? bf2f(X0b[(size_t)(t + 1) * 8]) : 0.f;
        const float x0c = cw[2048 + c] * xm + cw[3072 + 2048 + c] * xc + cw[6144 + 2048 + c] * xp + cb[2048 + c];
        const float sg = bf2f(GHb[(size_t)t * 8]);
        HG[(size_t)(rowbase + t) * DM + c] = (bf16)f2bf(acc * x0c * sg);
    }
}
namespace att {
typedef short bf16x8 __attribute__((ext_vector_type(8)));
typedef short s16x4 __attribute__((ext_vector_type(4)));
typedef float f32x16 __attribute__((ext_vector_type(16)));
constexpr int KROW = 144, KBUF = 64 * KROW;
constexpr int OFF_K = 0, OFF_V = 2 * KBUF, OFF_OST = 4 * KBUF, OFF_BIAS = OFF_OST + 8 * 4096, LDS_USED = OFF_BIAS + 15 * 128 * 4;
__device__ __forceinline__ s16x4 vtr(LAS const unsigned char* p) { return __builtin_bit_cast(s16x4, __builtin_amdgcn_ds_read_tr16_b64_v4i16((LAS s16x4*)p)); }
__device__ __forceinline__ unsigned cvtpk(float lo, float hi) { typedef float f2 __attribute__((ext_vector_type(2))); typedef __bf16 b2 __attribute__((ext_vector_type(2))); f2 v = {lo, hi}; b2 b = __builtin_convertvector(v, b2); return __builtin_bit_cast(unsigned, b); }

struct StepSrc { const bf16* k; const bf16* v; int dr; bool win; };

__device__ __forceinline__ void attn_unit(const Args& A, LAS unsigned char* lds, int lat, int b, int h, int qb) {
    const int tid = threadIdx.x, lane = tid & 63, wave = __builtin_amdgcn_readfirstlane(tid >> 6), r32 = lane & 31, hi = lane >> 5;
    bf16* PL = (bf16*)(A.ws + WS_PL);
    bf16* Qp = PL + 4 * PLANE_E; const bf16* Kp = PL + 5 * PLANE_E; const bf16* Vp = PL + 6 * PLANE_E; const bf16* GAp = PL + 7 * PLANE_E;
    const bf16* CK = (const bf16*)(A.ws + WS_CK); const bf16* CV = (const bf16*)(A.ws + WS_CV);
    const int rowbase = lat ? M_CTX + b * 1024 + qb * 256 : b * 256;
    const int qrow = rowbase + wave * 32 + r32;
    const int gr = qb * 4 + (wave >> 1), qc = 32 * (wave & 1) + r32;
    const int r0w = min(max(gr - 4, 0), 8), c0 = min(max(qc - 8, 0), 48);
    const int u0 = min(max(qb * 4 - 4, 0), 8), u1 = min(max(qb * 4 + 3 - 4, 0), 8) + 7;
    const int nwin = lat ? (u1 - u0 + 1) : 0, nsteps = nwin + 4;
    bf16x8 qr[4];
#pragma unroll
    for (int ks = 0; ks < 4; ++ks) qr[ks] = *(const bf16x8*)(Qp + (size_t)qrow * DM + h * HD + ks * 16 + hi * 8);
    if (lat) { LAS float* bl = (LAS float*)(lds + OFF_BIAS); const float* rpb = A.in[I_RPB] + h * 15 * 31;
        for (int i = tid; i < 15 * 128; i += NTHREADS) { const int rr = i >> 7, cc = (i & 127) - 48; bl[i] = (cc >= 0 && cc < 31) ? rpb[rr * 31 + cc] * LOG2E : 0.f; } }
    const int skey = tid >> 3, sch = tid & 7;
    auto step_k = [&](int i) -> const bf16* { if (!lat) return Kp + (size_t)(b * 256 + 64 * i) * DM + h * HD; if (i < nwin) return Kp + (size_t)(M_CTX + b * 1024 + (u0 + i) * 64) * DM + h * HD; return CK + (size_t)(b * 256 + 64 * (i - nwin)) * DM + h * HD; };
    auto step_v = [&](int i) -> const bf16* { if (!lat) return Vp + (size_t)(b * 256 + 64 * i) * DM + h * HD; if (i < nwin) return Vp + (size_t)(M_CTX + b * 1024 + (u0 + i) * 64) * DM + h * HD; return CV + (size_t)(b * 256 + 64 * (i - nwin)) * DM + h * HD; };
    v4u kreg = *(const v4u*)(step_k(0) + (size_t)skey * DM + sch * 8), vreg = *(const v4u*)(step_v(0) + (size_t)skey * DM + sch * 8);
    *(LAS v4u*)(lds + OFF_K + skey * KROW + sch * 16) = kreg; *(LAS v4u*)(lds + OFF_V + skey * KROW + sch * 16) = vreg;
    __syncthreads();
    float m_run = -1e30f, l_run = 0.f;
    f32x16 o0 = {}, o1 = {};
    for (int i = 0; i < nsteps; ++i) {
        const int buf = i & 1;
        if (i + 1 < nsteps) { kreg = *(const v4u*)(step_k(i + 1) + (size_t)skey * DM + sch * 8); vreg = *(const v4u*)(step_v(i + 1) + (size_t)skey * DM + sch * 8); }
        const bool win = lat && i < nwin; const int ur = u0 + i;
        const bool active = !win || (ur >= r0w && ur < r0w + 8);
        if (active) {
            LAS const unsigned char* kb = lds + OFF_K + buf * KBUF + r32 * KROW + hi * 16;
            f32x16 s0 = {}, s1 = {};
#pragma unroll
            for (int ks = 0; ks < 4; ++ks) { const bf16x8 k0 = *(LAS const bf16x8*)(kb + ks * 32), k1 = *(LAS const bf16x8*)(kb + 32 * KROW + ks * 32);
                s0 = __builtin_amdgcn_mfma_f32_32x32x16_bf16(k0, qr[ks], s0, 0, 0, 0); s1 = __builtin_amdgcn_mfma_f32_32x32x16_bf16(k1, qr[ks], s1, 0, 0, 0); }
            if (win) { LAS const float* bl = (LAS const float*)(lds + OFF_BIAS) + (ur - gr + 7) * 128 + (15 + 48 - qc + 4 * hi); const int lo = c0 - 4 * hi;
#pragma unroll
                for (int r = 0; r < 16; ++r) { const int kc = (r & 3) + 8 * (r >> 2);
                    s0[r] = ((unsigned)(kc - lo) < 16u) ? s0[r] + bl[kc] : -1e30f;
                    s1[r] = ((unsigned)(kc + 32 - lo) < 16u) ? s1[r] + bl[kc + 32] : -1e30f; } }
            float cm = fmaxf(s0[0], s1[0]);
#pragma unroll
            for (int r = 1; r < 16; ++r) cm = fmaxf(cm, fmaxf(s0[r], s1[r]));
            cm = fmaxf(cm, __shfl_xor(cm, 32));
            const float m_new = fmaxf(m_run, cm), alpha = __builtin_amdgcn_exp2f(m_run - m_new);
            m_run = m_new;
            float ps = 0.f;
#pragma unroll
            for (int r = 0; r < 16; ++r) { s0[r] = __builtin_amdgcn_exp2f(s0[r] - m_new); s1[r] = __builtin_amdgcn_exp2f(s1[r] - m_new); ps += s0[r] + s1[r]; }
            l_run = l_run * alpha + ps;
#pragma unroll
            for (int r = 0; r < 16; ++r) { o0[r] *= alpha; o1[r] *= alpha; }
            bf16x8 pf[4];
#pragma unroll
            for (int s2 = 0; s2 < 4; ++s2) { const f32x16& sv = (s2 < 2) ? s0 : s1; const int rb = 8 * (s2 & 1);
                v4u w; w.x = cvtpk(sv[rb + 0], sv[rb + 1]); w.y = cvtpk(sv[rb + 2], sv[rb + 3]); w.z = cvtpk(sv[rb + 4], sv[rb + 5]); w.w = cvtpk(sv[rb + 6], sv[rb + 7]);
                pf[s2] = __builtin_bit_cast(bf16x8, w); }
            LAS const unsigned char* vb = lds + OFF_V + buf * KBUF + (4 * (lane >> 5) + ((lane & 15) >> 2)) * KROW + (16 * ((lane >> 4) & 1) + 4 * (lane & 3)) * 2;
#pragma unroll
            for (int s2 = 0; s2 < 4; ++s2) {
                const s16x4 a0 = vtr(vb + (16 * s2) * KROW), a1 = vtr(vb + (16 * s2 + 8) * KROW), c0v = vtr(vb + (16 * s2) * KROW + 64), c1v = vtr(vb + (16 * s2 + 8) * KROW + 64);
                const bf16x8 v0 = {a0[0], a0[1], a0[2], a0[3], a1[0], a1[1], a1[2], a1[3]}, v1 = {c0v[0], c0v[1], c0v[2], c0v[3], c1v[0], c1v[1], c1v[2], c1v[3]};
                o0 = __builtin_amdgcn_mfma_f32_32x32x16_bf16(v0, pf[s2], o0, 0, 0, 0); o1 = __builtin_amdgcn_mfma_f32_32x32x16_bf16(v1, pf[s2], o1, 0, 0, 0); }
        }
        if (i + 1 < nsteps) { *(LAS v4u*)(lds + OFF_K + (buf ^ 1) * KBUF + skey * KROW + sch * 16) = kreg; *(LAS v4u*)(lds + OFF_V + (buf ^ 1) * KBUF + skey * KROW + sch * 16) = vreg; }
        __syncthreads();
    }
    l_run += __shfl_xor(l_run, 32);
    const float inv = 1.0f / l_run;
    LAS unsigned char* stg = lds + OFF_OST + wave * 4096;
#pragma unroll
    for (int g = 0; g < 4; ++g) {
        typedef unsigned u2 __attribute__((ext_vector_type(2)));
        u2 w0 = {cvtpk(o0[4 * g] * inv, o0[4 * g + 1] * inv), cvtpk(o0[4 * g + 2] * inv, o0[4 * g + 3] * inv)}, w1 = {cvtpk(o1[4 * g] * inv, o1[4 * g + 1] * inv), cvtpk(o1[4 * g + 2] * inv, o1[4 * g + 3] * inv)};
        *(LAS u2*)(stg + r32 * 128 + (8 * g + 4 * hi) * 2) = w0; *(LAS u2*)(stg + r32 * 128 + (32 + 8 * g + 4 * hi) * 2) = w1; }
    LDS_WAIT(); asm volatile("" ::: "memory");
#pragma unroll
    for (int i = 0; i < 4; ++i) { const int row = 8 * i + (lane >> 3), ch = lane & 7;
        const v4u ov = *(LAS const v4u*)(stg + row * 128 + ch * 16);
        const size_t go = (size_t)(rowbase + wave * 32 + row) * DM + h * HD + ch * 8;
        const v4u gv = *(const v4u*)(GAp + go);
        v4u r; r.x = cvtpk(pg8::bf_lo(ov.x) * pg8::bf_lo(gv.x), pg8::bf_hi(ov.x) * pg8::bf_hi(gv.x)); r.y = cvtpk(pg8::bf_lo(ov.y) * pg8::bf_lo(gv.y), pg8::bf_hi(ov.y) * pg8::bf_hi(gv.y));
        r.z = cvtpk(pg8::bf_lo(ov.z) * pg8::bf_lo(gv.z), pg8::bf_hi(ov.z) * pg8::bf_hi(gv.z)); r.w = cvtpk(pg8::bf_lo(ov.w) * pg8::bf_lo(gv.w), pg8::bf_hi(ov.w) * pg8::bf_hi(gv.w));
        *(v4u*)(Qp + go) = r; }
    __syncthreads();
}
__device__ __forceinline__ void phase_attn(const Args& A, LAS unsigned char* lds) {
    for (int u = blockIdx.x; u < 768; u += gridDim.x) {
        if (u < 256) { const int qb = (u & 1) ? ((u >> 1) & 1) * 3 : 1 + ((u >> 1) & 1);
            const int bh = u >> 2; attn_unit(A, lds, 1, bh >> 4, bh & 15, qb); }
        else { const int bh = u - 256; attn_unit(A, lds, 0, bh >> 4, bh & 15, 0); }
    }
}
}
__device__ __forceinline__ float dot64(const float (&q)[64], const bf16* k) {
    float s = 0.f;
#pragma unroll
    for (int i = 0; i < 8; ++i) { const v4u w = *(const v4u*)(k + 8 * i);
        s += q[8 * i + 0] * __uint_as_float(w.x << 16) + q[8 * i + 1] * __uint_as_float(w.x & 0xffff0000u) + q[8 * i + 2] * __uint_as_float(w.y << 16) + q[8 * i + 3] * __uint_as_float(w.y & 0xffff0000u)
           + q[8 * i + 4] * __uint_as_float(w.z << 16) + q[8 * i + 5] * __uint_as_float(w.z & 0xffff0000u) + q[8 * i + 6] * __uint_as_float(w.w << 16) + q[8 * i + 7] * __uint_as_float(w.w & 0xffff0000u); }
    return s;
}
__device__ __forceinline__ void phase_attn_naive(const Args& A) {
    const int tid = threadIdx.x, lane = tid & 63, wave = __builtin_amdgcn_readfirstlane(tid >> 6);
    const int gw = blockIdx.x * NWAVES + wave, NGW = gridDim.x * NWAVES;
    bf16* PL = (bf16*)(A.ws + WS_PL);
    bf16* Q = PL + 4 * PLANE_E; const bf16* K = PL + 5 * PLANE_E; const bf16* V = PL + 6 * PLANE_E; const bf16* GA = PL + 7 * PLANE_E;
    const bf16* CK = (const bf16*)(A.ws + WS_CK); const bf16* CV = (const bf16*)(A.ws + WS_CV);
    const float* rpb = A.in[I_RPB];
    for (int task = gw; task < M_ALL * NH; task += NGW) {
        const int row = task >> 4, h = task & 15;
        float q[64];
        { const bf16* qp = Q + (size_t)row * DM + h * HD;
#pragma unroll
          for (int i = 0; i < 8; ++i) { const v4u w = *(const v4u*)(qp + 8 * i);
              q[8 * i + 0] = __uint_as_float(w.x << 16); q[8 * i + 1] = __uint_as_float(w.x & 0xffff0000u); q[8 * i + 2] = __uint_as_float(w.y << 16); q[8 * i + 3] = __uint_as_float(w.y & 0xffff0000u);
              q[8 * i + 4] = __uint_as_float(w.z << 16); q[8 * i + 5] = __uint_as_float(w.z & 0xffff0000u); q[8 * i + 6] = __uint_as_float(w.w << 16); q[8 * i + 7] = __uint_as_float(w.w & 0xffff0000u); } }
        float sc[6]; int vrow[6];
        const bool lat = row >= M_CTX;
        if (!lat) { const int b = row >> 8;
#pragma unroll
            for (int j = 0; j < 4; ++j) { vrow[j] = b * 256 + j * 64 + lane; sc[j] = dot64(q, K + (size_t)vrow[j] * DM + h * HD); }
            sc[4] = -INFINITY; sc[5] = -INFINITY; vrow[4] = 0; vrow[5] = 0;
        } else { const int rl = row - M_CTX, b = rl >> 10, pos = rl & 1023, gr = pos >> 6, gc = pos & 63;
            const int r0 = min(max(gr - 4, 0), 8), c0 = min(max(gc - 8, 0), 48);
#pragma unroll
            for (int j = 0; j < 2; ++j) { const int kr = r0 + j * 4 + (lane >> 4), kc = c0 + (lane & 15); vrow[j] = M_CTX + b * 1024 + kr * 64 + kc;
                const float bias = rpb[(h * 15 + (kr - gr + 7)) * 31 + (kc - gc + 15)] * LOG2E;
                sc[j] = dot64(q, K + (size_t)vrow[j] * DM + h * HD) + bias; }
#pragma unroll
            for (int j = 0; j < 4; ++j) { vrow[2 + j] = b * 256 + j * 64 + lane; sc[2 + j] = dot64(q, CK + (size_t)vrow[2 + j] * DM + h * HD); }
        }
        float m = sc[0];
#pragma unroll
        for (int j = 1; j < 6; ++j) m = fmaxf(m, sc[j]);
        m = wave_max(m);
        float l = 0.f;
#pragma unroll
        for (int j = 0; j < 6; ++j) { sc[j] = __builtin_amdgcn_exp2f(sc[j] - m); l += sc[j]; }
        l = wave_sum(l);
        float o = 0.f;
#pragma unroll
        for (int j = 0; j < 6; ++j) {
            if (!lat && j >= 4) continue;
            const bf16* Vb = (lat && j >= 2) ? CV : V;
            for (int kk = 0; kk < 64; ++kk) { const float pk = __shfl(sc[j], kk); const int vr = __shfl(vrow[j], kk);
                o += pk * bf2f(Vb[(size_t)vr * DM + h * HD + lane]); }
        }
        const size_t oo = (size_t)row * DM + h * HD + lane;
        Q[oo] = (bf16)f2bf(o / l * bf2f(GA[oo]));
    }
}

__device__ __forceinline__ void phase_ln(const Args& A) {
    const int tid = threadIdx.x, lane = tid & 63, wave = __builtin_amdgcn_readfirstlane(tid >> 6);
    const int gw = blockIdx.x * NWAVES + wave, NGW = gridDim.x * NWAVES;
    const float* g = A.in[I_LNG]; const float* be = A.in[I_LNB];
    for (int row = gw; row < M_ALL; row += NGW) {
        float* y = A.out + (size_t)row * DM;
        f32x4 v[4]; float s = 0.f;
#pragma unroll
        for (int j = 0; j < 4; ++j) { v[j] = *(const f32x4*)(y + 256 * j + 4 * lane); s += (v[j].x + v[j].y) + (v[j].z + v[j].w); }
        const float mean = wave_sum(s) * (1.f / DM); float s2 = 0.f;
#pragma unroll
        for (int j = 0; j < 4; ++j) { v[j] = v[j] - mean; s2 += (v[j].x * v[j].x + v[j].y * v[j].y) + (v[j].z * v[j].z + v[j].w * v[j].w); }
        const float rstd = 1.f / sqrtf(wave_sum(s2) * (1.f / DM) + LN_EPS);
#pragma unroll
        for (int j = 0; j < 4; ++j) { const f32x4 gg = *(const f32x4*)(g + 256 * j + 4 * lane), bb = *(const f32x4*)(be + 256 * j + 4 * lane);
            *(f32x4*)(y + 256 * j + 4 * lane) = v[j] * rstd * gg + bb; }
    }
}

__global__ void __launch_bounds__(NWAVES * 64, 2) fwd_kernel(Args args) {
    extern __shared__ __attribute__((aligned(16))) unsigned char lds_raw[];
    LAS unsigned char* lds = (LAS unsigned char*)lds_raw;
    const int tid = threadIdx.x;
    for (int u = tid; u < (LDS_BYTES - LDSCTL_OFF) / 4; u += NWAVES * 64) ((LAS unsigned*)(lds + LDSCTL_OFF))[u] = 0u;
    __syncthreads();
    const int lo = args.ph_lo, hi = args.ph_hi;
    const bool use_bar = (hi - lo) > 1;
    gu32* ctl = (gu32*)(args.ws + WS_CTL);
    XcdBarrier bar; bar.bar = (unsigned*)(ctl + CW_BAR) + args.li * XCD_BAR_WORDS; bar.x = 0; bar.st = nullptr;
    if (use_bar) bar = xcd_barrier_post((unsigned*)(ctl + CW_BAR) + args.li * XCD_BAR_WORDS, (volatile LAS unsigned*)(lds + MISC_OFF) + 8);
#define IN(k) (lo <= (k) && (k) < hi)
#define SEAM(k) do { if (IN(k) && IN((k) + 1)) xcd_barrier(bar); } while (0)
    bf16* PL = (bf16*)(args.ws + WS_PL);
    if (IN(0)) { phase_prologue(args, lds); SEAM(0); }
    if (IN(1)) { phase_xn(args); SEAM(1); }
    if (IN(2)) {
        pg8::Gemm g{(const bf16*)(args.ws + WS_XN), (const bf16*)(args.ws + WS_WIN), M_ALL, D_IN, DM}; pg8::StaticOrder S; S.init(M_ALL, D_IN, gridDim.x, (int)blockIdx.x);
        pg8::EpiProj E{PL, (bf16*)args.out, args.out + (size_t)M_ALL * DM, args.out + (size_t)M_ALL * DM + (size_t)M_CTX * DM, C2};
        pg8::gemm_phase<pg8::EpiProj, pg8::StaticOrder, true, true>(lds, g, S, E);
        SEAM(2);
    }
    if (IN(3)) { phase_hyena_u(args); SEAM(3); }
    if (IN(4)) { phase_hyena_conv_naive(args); att::phase_attn(args, lds); SEAM(4); }
    if (IN(5)) {
        pg8::Gemm g{PL, (const bf16*)(args.ws + WS_WBH), M_ALL, DM, DM}; pg8::StaticOrder S; S.init(M_ALL, DM, gridDim.x, (int)blockIdx.x);
        pg8::EpiGate E{(const bf16*)args.out, nullptr, PL + PLANE_E};
        pg8::gemm_phase<pg8::EpiGate, pg8::StaticOrder, true, true>(lds, g, S, E);
        SEAM(5);
    }
    if (IN(6)) {
        pg8::Gemm g{PL + 4 * PLANE_E, (const bf16*)(args.ws + WS_WBA), M_ALL, DM, DM}; pg8::StaticOrder S; S.init(M_ALL, DM, gridDim.x, (int)blockIdx.x);
        pg8::EpiGate E{(const bf16*)args.out + PLANE_E, PL + PLANE_E, PL + 2 * PLANE_E};
        pg8::gemm_phase<pg8::EpiGate, pg8::StaticOrder, true, true>(lds, g, S, E);
        SEAM(6);
    }
    if (IN(7)) {
        pg8::Gemm g{PL + 2 * PLANE_E, (const bf16*)(args.ws + WS_WOUT), M_ALL, DM, DM}; pg8::StaticOrder S; S.init(M_ALL, DM, gridDim.x, (int)blockIdx.x);
        pg8::EpiResid E{args.in[I_XP], args.in[I_XS], (const float*)(args.ws + WS_MOD), args.out, ALPHA};
        pg8::gemm_phase<pg8::EpiResid, pg8::StaticOrder, true, true>(lds, g, S, E);
        SEAM(7);
    }
    if (IN(8)) { phase_ln(args); }
#undef IN
#undef SEAM
}

#ifndef N_LAUNCH_MODE
#define N_LAUNCH_MODE 1
#endif
extern "C" void kernel_launch(void* const* d_in, const int* in_sizes, int n_in, void* d_out, int out_size, void* d_ws, size_t ws_size, hipStream_t stream) {
    static int grid = 0;
    if (grid == 0) {
        if (n_in != 24 || ws_size < WS_END) { fprintf(stderr, "kernel_launch: unexpected n_in %d / ws_size %zu\n", n_in, ws_size); grid = -1; return; }
        int dev = 0, cus = 0, per_cu = 0;
        if (hipGetDevice(&dev) != hipSuccess || hipDeviceGetAttribute(&cus, hipDeviceAttributeMultiprocessorCount, dev) != hipSuccess) { grid = -1; return; }
        if (hipFuncSetAttribute((const void*)fwd_kernel, hipFuncAttributeMaxDynamicSharedMemorySize, LDS_BYTES) != hipSuccess) { fprintf(stderr, "kernel_launch: hipFuncSetAttribute failed\n"); grid = -1; return; }
        if (hipOccupancyMaxActiveBlocksPerMultiprocessor(&per_cu, (const void*)fwd_kernel, NWAVES * 64, LDS_BYTES) != hipSuccess || per_cu < 1) { fprintf(stderr, "kernel_launch: occupancy query says %d blocks per CU\n", per_cu); per_cu = 1; }
        (void)hipGetLastError();
        grid = cus;
    }
    if (grid < 0) return;
    (void)hipMemsetAsync((char*)d_ws + WS_CTL, 0, CTL_ZERO_BYTES, stream);
    Args a{};
    for (int i = 0; i < 24; ++i) a.in[i] = (const float*)d_in[i];
    a.out = (float*)d_out; a.ws = (unsigned char*)d_ws;
    if (N_LAUNCH_MODE == 1) {
        a.ph_lo = 0; a.ph_hi = N_PHASES; a.li = 0;
        hipLaunchKernelGGL(fwd_kernel, dim3(grid), dim3(NWAVES * 64), LDS_BYTES, stream, a);
    } else {
        for (int p = 0; p < N_PHASES; ++p) { a.ph_lo = p; a.ph_hi = p + 1; a.li = 0;
            hipLaunchKernelGGL(fwd_kernel, dim3(grid), dim3(NWAVES * 64), LDS_BYTES, stream, a); }
    }
}
```

```cpp
#include <hip/hip_runtime.h>
#include <cstdio>
#include <cstdint>
#include <cmath>
namespace pg8 {
#define PG8_LAS __attribute__((address_space(3)))
typedef unsigned short bf16_t;
typedef short bf16x8 __attribute__((ext_vector_type(8)));
typedef float f32x4 __attribute__((ext_vector_type(4)));
typedef unsigned u32x4 __attribute__((ext_vector_type(4)));
constexpr int BM = 256, BK = 64, HALF = 128, HTB = HALF * BK * 2  , STAGE_BYTES = 8 * HTB, NXCD = 8, WGM = 8;

__host__ __device__ __forceinline__ int lds_byte(int r, int c) { const int st = (r >> 4) * 2 + (c >> 5), rr = r & 15, cc = c & 31, ob = rr * 64 + cc * 2; return st * 1024 + (ob ^ (((ob >> 9) & 1) << 5)); }
__host__ __device__ __forceinline__ void stage_rc(int b, int& R, int& C) { const int st = b / 1024, sb = b % 1024, swz = sb ^ (((sb >> 9) & 1) << 5); R = (st >> 1) * 16 + swz / 64; C = (st & 1) * 32 + (swz % 64) / 2; }
__host__ __device__ __forceinline__ int perm32(int rho) { const int n = rho >> 4, i = rho & 15; return 8 * (i >> 2) + 4 * n + (i & 3); }

struct Unit { int pm, pn; };
struct Gemm { const bf16_t* A; const bf16_t* Bt; int M, N, K; };

struct StaticOrder {
    int nM, nN, nwg, G, c;
    __host__ __device__ void init(int M, int N, int G_, int c_) { nM = M / BM; nN = N / BM; nwg = nM * nN; G = G_; c = c_; }
    __host__ __device__ bool next(int i, Unit& u) const {
        const long L = (long)i * G + c; if (L >= nwg) return false;
        int wgid = (int)L; { const int q = nwg / NXCD, r = nwg % NXCD, xcd = wgid % NXCD, off = wgid / NXCD; wgid = (xcd < r ? xcd * (q + 1) : r * (q + 1) + (xcd - r) * q) + off; }
        const int nig = WGM * nN, gid = wgid / nig, fm = gid * WGM, gsz = (nM - fm) < WGM ? (nM - fm) : WGM;
        u.pm = fm + ((wgid % nig) % gsz); u.pn = (wgid % nig) / gsz; return true;
    }
    __device__ __forceinline__ void a_ready(const Unit&) const {}
    __device__ __forceinline__ void done(const Unit&) const {}
};

__device__ __forceinline__ unsigned cvt_pk_bf16(float lo, float hi) { unsigned r; asm volatile("v_cvt_pk_bf16_f32 %0, %1, %2" : "=v"(r) : "v"(lo), "v"(hi)); return r; }
typedef float f32x2 __attribute__((ext_vector_type(2)));
__device__ __forceinline__ f32x2 gelu_pk(f32x2 v) {
    const f32x2 av = __builtin_elementwise_abs(v), d = av * 0.2316418882f + 1.0f;
    f32x2 t; t.x = __builtin_amdgcn_rcpf(d.x); t.y = __builtin_amdgcn_rcpf(d.y);
    f32x2 q = t * 0.5307027145f + (-0.7265760135f); q = q * t + 0.7107068705f; q = q * t + (-0.142248368f); q = q * t + 0.127414796f; q = q * t;
    const f32x2 s = (v * v) * (-0.72134752044f);
    f32x2 e; e.x = __builtin_amdgcn_exp2f(s.x); e.y = __builtin_amdgcn_exp2f(s.y);
    const f32x2 m = v * (q * e), r = v - m;
    f32x2 o; o.x = v.x < 0.f ? m.x : r.x; o.y = v.y < 0.f ? m.y : r.y; return o;
}

typedef unsigned u32x2e __attribute__((ext_vector_type(2)));
__device__ __forceinline__ float sigmoid_f(float x) { return __builtin_amdgcn_rcpf(1.0f + __builtin_amdgcn_exp2f(-1.4426950408889634f * x)); }
constexpr int EP_M = 12288;
constexpr size_t EP_PLANE = (size_t)EP_M * 1024;
struct EpiProj {
    static constexpr bool PERM = true, AFTER_DRAIN = false;
    bf16_t* planes;
    bf16_t* mplanes;
    float* newk; float* newv;
    float qscale;
    __device__ __forceinline__ void operator()(const f32x4 (&acc)[2][2][4][2], const Unit& u, int wr, int wc, int fr, int fq) const {
        const int t = u.pn >> 2;
        const int row0 = u.pm * BM + wr * 64 + fr, colp0 = (u.pn & 3) * BM + wc * 32 + 8 * fq;
        bf16_t* base = (t < 8) ? planes + (size_t)t * EP_PLANE : mplanes + (size_t)(t - 8) * EP_PLANE;
        const bool chunk = t < 4;
        const int mode = (t == 3 || t == 7) ? 1 : (t >= 8 ? 2 : (t == 4 ? 3 : 0));
        float* f32o = (u.pm < 32) ? (t == 5 ? newk : (t == 6 ? newv : nullptr)) : nullptr;
#pragma unroll
        for (int ai = 0; ai < 2; ++ai)
#pragma unroll
            for (int m = 0; m < 4; ++m) { const int row = row0 + ai * HALF + m * 16;
#pragma unroll
                for (int bj = 0; bj < 2; ++bj) { const int col = colp0 + bj * HALF;
                    f32x4 v0 = acc[ai][bj][m][0], v1 = acc[ai][bj][m][1];
                    if (f32o) { float* p = f32o + (size_t)row * 1024 + col; *(f32x4*)p = v0; *(f32x4*)(p + 4) = v1; }
                    if (mode == 1) {
#pragma unroll
                        for (int e = 0; e < 4; ++e) { v0[e] = v0[e] * sigmoid_f(v0[e]); v1[e] = v1[e] * sigmoid_f(v1[e]); }
                    } else if (mode == 2) {
#pragma unroll
                        for (int e = 0; e < 4; ++e) { v0[e] = sigmoid_f(v0[e]); v1[e] = sigmoid_f(v1[e]); }
                    } else if (mode == 3) { v0 = v0 * qscale; v1 = v1 * qscale; }
                    u32x4 w; w.x = cvt_pk_bf16(v0[0], v0[1]); w.y = cvt_pk_bf16(v0[2], v0[3]); w.z = cvt_pk_bf16(v1[0], v1[1]); w.w = cvt_pk_bf16(v1[2], v1[3]);
                    bf16_t* dst = chunk ? base + ((size_t)(col >> 3) * EP_M + row) * 8 : base + (size_t)row * 1024 + col;
                    *(u32x4*)dst = w; } }
    }
};
__device__ __forceinline__ float bf_lo(unsigned w) { return __uint_as_float(w << 16); }
__device__ __forceinline__ float bf_hi(unsigned w) { return __uint_as_float(w & 0xffff0000u); }
struct EpiGate {
    static constexpr bool PERM = true, AFTER_DRAIN = false;
    const bf16_t* gate; const bf16_t* prev; bf16_t* O;
    __device__ __forceinline__ void operator()(const f32x4 (&acc)[2][2][4][2], const Unit& u, int wr, int wc, int fr, int fq) const {
        const int row0 = u.pm * BM + wr * 64 + fr, col0 = u.pn * BM + wc * 32 + 8 * fq;
#pragma unroll
        for (int ai = 0; ai < 2; ++ai)
#pragma unroll
            for (int m = 0; m < 4; ++m) { const size_t ro = (size_t)(row0 + ai * HALF + m * 16) * 1024 + col0;
#pragma unroll
                for (int bj = 0; bj < 2; ++bj) { const size_t o = ro + bj * HALF;
                    const u32x4 g = *(const u32x4*)(gate + o);
                    f32x4 v0 = acc[ai][bj][m][0], v1 = acc[ai][bj][m][1];
                    v0[0] *= bf_lo(g.x); v0[1] *= bf_hi(g.x); v0[2] *= bf_lo(g.y); v0[3] *= bf_hi(g.y);
                    v1[0] *= bf_lo(g.z); v1[1] *= bf_hi(g.z); v1[2] *= bf_lo(g.w); v1[3] *= bf_hi(g.w);
                    if (prev) { const u32x4 p = *(const u32x4*)(prev + o);
                        v0[0] += bf_lo(p.x); v0[1] += bf_hi(p.x); v0[2] += bf_lo(p.y); v0[3] += bf_hi(p.y);
                        v1[0] += bf_lo(p.z); v1[1] += bf_hi(p.z); v1[2] += bf_lo(p.w); v1[3] += bf_hi(p.w); }
                    u32x4 w; w.x = cvt_pk_bf16(v0[0], v0[1]); w.y = cvt_pk_bf16(v0[2], v0[3]); w.z = cvt_pk_bf16(v1[0], v1[1]); w.w = cvt_pk_bf16(v1[2], v1[3]);
                    *(u32x4*)(O + o) = w; } }
    }
};
struct EpiResid {
    static constexpr bool PERM = true, AFTER_DRAIN = false;
    const float* xp; const float* xs; const float* mod; float* V; float alpha;
    __device__ __forceinline__ void operator()(const f32x4 (&acc)[2][2][4][2], const Unit& u, int wr, int wc, int fr, int fq) const {
        const int row0 = u.pm * BM + wr * 64 + fr, col0 = u.pn * BM + wc * 32 + 8 * fq;
        const int cond = (u.pm < 32) ? 0 : 1 + ((u.pm - 32) >> 2);
        const float* x = (u.pm < 32) ? xp : xs - (size_t)8192 * 1024;
        f32x4 g[2][2];
#pragma unroll
        for (int bj = 0; bj < 2; ++bj) { g[bj][0] = *(const f32x4*)(mod + cond * 3072 + 2048 + col0 + bj * HALF); g[bj][1] = *(const f32x4*)(mod + cond * 3072 + 2048 + col0 + bj * HALF + 4); }
#pragma unroll
        for (int ai = 0; ai < 2; ++ai)
#pragma unroll
            for (int m = 0; m < 4; ++m) { const size_t ro = (size_t)(row0 + ai * HALF + m * 16) * 1024 + col0;
#pragma unroll
                for (int bj = 0; bj < 2; ++bj) { const size_t o = ro + bj * HALF;
                    const f32x4 x0 = *(const f32x4*)(x + o), x1 = *(const f32x4*)(x + o + 4);
                    *(f32x4*)(V + o) = x0 * alpha + g[bj][0] * acc[ai][bj][m][0];
                    *(f32x4*)(V + o + 4) = x1 * alpha + g[bj][1] * acc[ai][bj][m][1]; } }
    }
};
template <class Epi, class Sched, bool ALIGN_EPI = false, bool SP2 = false, bool A_CHUNK = false>
__device__ __forceinline__ void gemm_phase(PG8_LAS unsigned char* lds, const Gemm g, const Sched& S, const Epi& E) {
    const int tid = threadIdx.x, wid = __builtin_amdgcn_readfirstlane(tid >> 6), lane = tid & 63, wr = wid >> 2, wc = wid & 3, fr = lane & 15, fq = lane >> 4;
    const int K = g.K, nt = K / BK;
    unsigned voffA[2], voffB[2];
#pragma unroll
    for (int i = 0; i < 2; ++i) { int R, C; stage_rc(tid * 16 + i * 8192, R, C); const int Rb = Epi::PERM ? ((R & ~31) + perm32(R & 31)) : R;
        voffA[i] = A_CHUNK ? (unsigned)((C >> 3) * 12288 + R) * 16u : (unsigned)(R * K + C) * 2u; voffB[i] = (unsigned)(Rb * K + C) * 2u; }
    const size_t kstep = (size_t)(BK * 2);
    const size_t hstep = (size_t)HALF * K * 2;
    const size_t tstep = 2 * hstep;
    const size_t kstepA = A_CHUNK ? (size_t)8 * 12288 * 16 : kstep, hstepA = A_CHUNK ? (size_t)HALF * 16 : hstep, tstepA = 2 * hstepA;
    const unsigned ldsw = (unsigned)wid * 1024u;
    const int aoff = lds_byte(wr * 64 + fr, fq * 8), boff = lds_byte(wc * 32 + fr, fq * 8);
#define PG8_SA(b, h) (((b) * 2 + (h)) * HTB)
#define PG8_SB(b, h) ((4 + (b) * 2 + (h)) * HTB)
#define PG8_STAGE(bufoff, gbase, voff) do { _Pragma("unroll") for (int _i = 0; _i < 2; ++_i) \
        __builtin_amdgcn_global_load_lds((const unsigned*)((const char*)(gbase) + (voff)[_i]), (PG8_LAS unsigned*)(lds + (bufoff) + ldsw + _i * 8192), 16, 0, 0); } while (0)
#define PG8_LDA(dst, b, h) do { _Pragma("unroll") for (int m = 0; m < 4; ++m) _Pragma("unroll") for (int k = 0; k < 2; ++k) dst[m][k] = *(const PG8_LAS bf16x8*)(lds + PG8_SA(b, h) + aoff + m * 2048 + k * 1024); } while (0)
#define PG8_LDB(dst, b, h) do { _Pragma("unroll") for (int n = 0; n < 2; ++n) _Pragma("unroll") for (int k = 0; k < 2; ++k) dst[n][k] = *(const PG8_LAS bf16x8*)(lds + PG8_SB(b, h) + boff + n * 2048 + k * 1024); } while (0)
#define PG8_MMA(ai, bj, At, Bt) do { __builtin_amdgcn_s_setprio(1); _Pragma("unroll") for (int m = 0; m < 4; ++m) _Pragma("unroll") for (int n = 0; n < 2; ++n) _Pragma("unroll") for (int k = 0; k < 2; ++k) \
        acc[ai][bj][m][n] = __builtin_amdgcn_mfma_f32_16x16x32_bf16(Bt[n][k], At[m][k], acc[ai][bj][m][n], 0, 0, 0); __builtin_amdgcn_s_setprio(0); } while (0)
#define PG8_WAIT_V(n) asm volatile("s_waitcnt vmcnt(" #n ")" ::: "memory")
#define PG8_WAIT_L(n) asm volatile("s_waitcnt lgkmcnt(" #n ")" ::: "memory")
#define PG8_BAR __builtin_amdgcn_s_barrier()
#define PG8_SCHED __builtin_amdgcn_sched_barrier(0)
    Unit cur, nxt; int ui = 0;
    if (!S.next(0, cur)) return;
    f32x4 acc[2][2][4][2];
#pragma unroll
    for (int a = 0; a < 2; ++a)
#pragma unroll
        for (int b = 0; b < 2; ++b)
#pragma unroll
            for (int m = 0; m < 4; ++m)
#pragma unroll
                for (int n = 0; n < 2; ++n) acc[a][b][m][n] = (f32x4){0.f, 0.f, 0.f, 0.f};
    bf16x8 At[4][2], B0[2][2], B1[2][2];
    const char* cA = (const char*)g.A + (size_t)cur.pm * tstepA; const char* cB = (const char*)g.Bt + (size_t)cur.pn * tstep;
    S.a_ready(cur);
    if constexpr (SP2) {
        PG8_STAGE(PG8_SB(0, 0), cB, voffB); PG8_STAGE(PG8_SB(0, 1), cB + hstep, voffB); PG8_STAGE(PG8_SA(0, 0), cA, voffA); PG8_STAGE(PG8_SA(0, 1), cA + hstepA, voffA);
        if (wr == 1) PG8_BAR;
        PG8_WAIT_V(2); PG8_BAR;
        PG8_STAGE(PG8_SB(1, 0), cB + kstep, voffB); PG8_STAGE(PG8_SA(1, 0), cA + kstepA, voffA); PG8_STAGE(PG8_SB(1, 1), cB + hstep + kstep, voffB);
        PG8_WAIT_V(6); PG8_BAR;
    } else {
        PG8_STAGE(PG8_SB(0, 0), cB, voffB); PG8_STAGE(PG8_SA(0, 0), cA, voffA); PG8_STAGE(PG8_SB(0, 1), cB + hstep, voffB); PG8_STAGE(PG8_SA(0, 1), cA + hstepA, voffA);
        if (wr == 1) PG8_BAR;
        PG8_WAIT_V(4); PG8_BAR;
        PG8_STAGE(PG8_SB(1, 0), cB + kstep, voffB); PG8_STAGE(PG8_SA(1, 0), cA + kstepA, voffA); PG8_STAGE(PG8_SB(1, 1), cB + hstep + kstep, voffB);
        PG8_WAIT_V(6); PG8_BAR;
    }
    for (;;) {
        const bool has_next = S.next(ui + 1, nxt);
        const char* nA = has_next ? (const char*)g.A + (size_t)nxt.pm * tstepA : cA; const char* nB = has_next ? (const char*)g.Bt + (size_t)nxt.pn * tstep : cB;
        for (int t = 0; t < nt; t += 2) {
            const bool last = (t == nt - 2);
            const char* a1 = cA + (size_t)(t + 1) * kstepA;
            const char* a2 = last ? nA : cA + (size_t)(t + 2) * kstepA; const char* b2 = last ? nB : cB + (size_t)(t + 2) * kstep;
            const char* a3 = a2 + kstepA; const char* b3 = b2 + kstep;
            if (last && has_next) S.a_ready(nxt);
            if constexpr (SP2) {
            PG8_LDB(B0, 0, 0); PG8_LDB(B1, 0, 1); PG8_SCHED; PG8_LDA(At, 0, 0); PG8_STAGE(PG8_SA(1, 1), a1 + hstepA, voffA);
            PG8_WAIT_V(8); PG8_WAIT_L(0); PG8_BAR; PG8_MMA(0, 0, At, B0); PG8_MMA(0, 1, At, B1); PG8_BAR; PG8_SCHED;
            PG8_LDA(At, 0, 1); PG8_STAGE(PG8_SB(0, 0), b2, voffB); PG8_STAGE(PG8_SB(0, 1), b2 + hstep, voffB); PG8_STAGE(PG8_SA(0, 0), a2, voffA);
            PG8_WAIT_V(8); PG8_WAIT_L(0); PG8_BAR; PG8_MMA(1, 0, At, B0); PG8_MMA(1, 1, At, B1); PG8_BAR; PG8_SCHED;
            PG8_LDB(B0, 1, 0); PG8_LDB(B1, 1, 1); PG8_SCHED; PG8_LDA(At, 1, 0); PG8_STAGE(PG8_SA(0, 1), a2 + hstepA, voffA);
            PG8_WAIT_V(8); PG8_WAIT_L(0); PG8_BAR; PG8_MMA(0, 0, At, B0); PG8_MMA(0, 1, At, B1); PG8_BAR; PG8_SCHED;
            PG8_LDA(At, 1, 1); PG8_STAGE(PG8_SB(1, 0), b3, voffB); PG8_STAGE(PG8_SB(1, 1), b3 + hstep, voffB); PG8_STAGE(PG8_SA(1, 0), a3, voffA);
            PG8_WAIT_V(8); PG8_WAIT_L(0); PG8_BAR; PG8_MMA(1, 0, At, B0); PG8_MMA(1, 1, At, B1); PG8_BAR; PG8_SCHED;
            } else {
            PG8_LDB(B0, 0, 0); PG8_SCHED; PG8_LDA(At, 0, 0); PG8_STAGE(PG8_SA(1, 1), a1 + hstepA, voffA);
            PG8_WAIT_L(8); PG8_BAR; PG8_WAIT_L(0); PG8_MMA(0, 0, At, B0); PG8_BAR; PG8_SCHED;
            PG8_LDB(B1, 0, 1); PG8_STAGE(PG8_SB(0, 0), b2, voffB);
            PG8_BAR; PG8_WAIT_L(0); PG8_MMA(0, 1, At, B1); PG8_BAR;
            PG8_LDA(At, 0, 1); PG8_STAGE(PG8_SA(0, 0), a2, voffA);
            PG8_BAR; PG8_WAIT_L(0); PG8_MMA(1, 0, At, B0); PG8_BAR; PG8_SCHED;
            PG8_STAGE(PG8_SB(0, 1), b2 + hstep, voffB);
            PG8_WAIT_V(6); PG8_BAR; PG8_MMA(1, 1, At, B1); PG8_BAR;
            PG8_LDB(B0, 1, 0); PG8_SCHED; PG8_LDA(At, 1, 0); PG8_STAGE(PG8_SA(0, 1), a2 + hstepA, voffA);
            PG8_WAIT_L(8); PG8_BAR; PG8_WAIT_L(0); PG8_MMA(0, 0, At, B0); PG8_BAR; PG8_SCHED;
            PG8_LDB(B1, 1, 1); PG8_STAGE(PG8_SB(1, 0), b3, voffB);
            PG8_BAR; PG8_WAIT_L(0); PG8_MMA(0, 1, At, B1); PG8_BAR;
            PG8_LDA(At, 1, 1); PG8_STAGE(PG8_SA(1, 0), a3, voffA);
            PG8_BAR; PG8_WAIT_L(0); PG8_MMA(1, 0, At, B0); PG8_BAR; PG8_SCHED;
            PG8_STAGE(PG8_SB(1, 1), b3 + hstep, voffB);
            PG8_WAIT_V(6); PG8_BAR; PG8_MMA(1, 1, At, B1); PG8_BAR;
            }
        }
        if constexpr (ALIGN_EPI) { if (wr == 0) PG8_BAR; }
        if constexpr (!Epi::AFTER_DRAIN) { E(acc, cur, wr, wc, fr, fq); S.done(cur); }
        if (!has_next) break;
#pragma unroll
        for (int a = 0; a < 2; ++a)
#pragma unroll
            for (int b = 0; b < 2; ++b)
#pragma unroll
                for (int m = 0; m < 4; ++m)
#pragma unroll
                    for (int n = 0; n < 2; ++n) acc[a][b][m][n] = (f32x4){0.f, 0.f, 0.f, 0.f};
        cur = nxt; cA = nA; cB = nB; ++ui;
        if constexpr (ALIGN_EPI) { if (wr == 1) PG8_BAR; }
    }
    PG8_WAIT_V(0);
    if constexpr (!ALIGN_EPI) { if (wr == 0) PG8_BAR; }
    PG8_BAR;
    if constexpr (Epi::AFTER_DRAIN) { E.fused(acc, cur, wr, wc, fr, fq, lds, wid, lane); S.done(cur); }
#undef PG8_SA
#undef PG8_SB
#undef PG8_STAGE
#undef PG8_LDA
#undef PG8_LDB
#undef PG8_MMA
#undef PG8_WAIT_V
#undef PG8_WAIT_L
#undef PG8_BAR
#undef PG8_SCHED
}
}
#define GAS __attribute__((address_space(1)))
#define LAS __attribute__((address_space(3)))
typedef unsigned short bf16;
typedef unsigned v4u __attribute__((ext_vector_type(4)));
typedef float f32x4 __attribute__((ext_vector_type(4)));
typedef short bf16x8 __attribute__((ext_vector_type(8)));
typedef GAS unsigned gu32;
typedef GAS unsigned long long gu64;
#define RLX_AGENT __ATOMIC_RELAXED, __HIP_MEMORY_SCOPE_AGENT
#define LDS_WAIT() asm volatile("s_waitcnt lgkmcnt(0)" ::: "memory")
#define VM_WAIT() asm volatile("s_waitcnt vmcnt(0)" ::: "memory")
__device__ __forceinline__ unsigned long long rt() { return __builtin_amdgcn_s_memrealtime(); }
__device__ __forceinline__ unsigned f2bf(float f) { unsigned u = __builtin_bit_cast(unsigned, f); return (u + 0x7fffu + ((u >> 16) & 1u)) >> 16; }
__device__ __forceinline__ unsigned pk2(float lo, float hi) { return f2bf(lo) | (f2bf(hi) << 16); }

#define XB_TMO      128
#define XB_XCNT(j)  (256  + 64 * (j))
#define XB_XSUB(j)  (1280 + 64 * (j))
#define XB_XGEN(j)  (2304 + 64 * (j))
#define XB_TOP      3328
#define XB_TOPGEN   3392
#define XCD_BAR_WORDS 3456
#define XB_SPIN_CAP (1u << 18)

__device__ __forceinline__ unsigned xb_ld(unsigned* p)              { return __hip_atomic_load(p, __ATOMIC_RELAXED, __HIP_MEMORY_SCOPE_AGENT); }
__device__ __forceinline__ unsigned xb_add(unsigned* p, unsigned v) { return __hip_atomic_fetch_add(p, v, __ATOMIC_RELAXED, __HIP_MEMORY_SCOPE_AGENT); }
__device__ __forceinline__ unsigned xb_xcc_id() { return (unsigned)__builtin_amdgcn_s_getreg((3 << 11) | 20) & 0xFu; }
#define XB_SPIN(cond, bar) do { unsigned _sp = 0; while (cond) { __builtin_amdgcn_s_sleep(1); \
    if ((++_sp & 255u) == 0u) { if (xb_ld(&(bar)[XB_TMO])) break; if (_sp > XB_SPIN_CAP) { atomicAdd(&(bar)[XB_TMO], 1u); break; } } } } while (0)

struct XcdBarrier {
    unsigned* bar; unsigned x;
    volatile LAS unsigned* st;
};

__device__ __forceinline__ XcdBarrier xcd_barrier_post(unsigned* bar, volatile LAS unsigned* st) {
    XcdBarrier b; b.bar = bar; b.x = xb_xcc_id(); b.st = st;
    if (threadIdx.x == 0) (void)xb_add(&bar[XB_XCNT(b.x)], 1u);
    return b;
}
__device__ __forceinline__ void xcd_barrier_complete(unsigned* bar, unsigned x, unsigned& nloc, unsigned& nx) {
    const unsigned G = gridDim.x * gridDim.y * gridDim.z;
    unsigned sum, cnt, mine, sp = 0u;
    for (;;) {
        sum = 0u; cnt = 0u; mine = 0u;
#pragma unroll
        for (unsigned j = 0; j < 16; ++j) { const unsigned c = xb_ld(&bar[XB_XCNT(j)]); sum += c; cnt += (c > 0u) ? 1u : 0u; mine = (j == x) ? c : mine; }
        if (sum == G) break;
        __builtin_amdgcn_s_sleep(1);
        if ((++sp & 255u) == 0u) { if (xb_ld(&bar[XB_TMO])) break; if (sp > XB_SPIN_CAP) { atomicAdd(&bar[XB_TMO], 1u); break; } }
    }
    nloc = mine > 0u ? mine : 1u; nx = cnt > 0u ? cnt : 1u;
}

__device__ __forceinline__ void xcd_barrier(const XcdBarrier& b) {
    asm volatile("s_waitcnt vmcnt(0)" ::: "memory");
    __syncthreads();
    if (threadIdx.x == 0) {
        unsigned* bar = b.bar;
        __builtin_amdgcn_s_waitcnt(0);
        unsigned nloc = b.st[0], nx = b.st[1];
        if (nloc == 0u) { xcd_barrier_complete(bar, b.x, nloc, nx); b.st[0] = nloc; b.st[1] = nx; }
        const unsigned old = xb_add(&bar[XB_XSUB(b.x)], 1u);
        const unsigned gen = old / nloc;
        if (old + 1u == (gen + 1u) * nloc) {
            __builtin_amdgcn_fence(__ATOMIC_RELEASE, "agent");
            asm volatile("s_waitcnt vmcnt(0)" ::: "memory");
            const unsigned og = xb_add(&bar[XB_TOP], 1u);
            const unsigned tg = og / nx;
            if (og + 1u == (tg + 1u) * nx) xb_add(&bar[XB_TOPGEN], 1u);
            else XB_SPIN(xb_ld(&bar[XB_TOPGEN]) == tg, bar);
            __builtin_amdgcn_fence(__ATOMIC_ACQUIRE, "agent");
            xb_add(&bar[XB_XGEN(b.x)], 1u);
            asm volatile("s_waitcnt vmcnt(0)" ::: "memory");
        } else {
            XB_SPIN(xb_ld(&bar[XB_XGEN(b.x)]) == gen, bar);
            __builtin_amdgcn_fence(__ATOMIC_ACQUIRE, "agent");
            asm volatile("s_waitcnt vmcnt(0)" ::: "memory");
        }
    }
    __syncthreads();
}
constexpr int NWAVES = 8, NTHREADS = 512;
constexpr int DM = 1024, M_CTX = 8192, M_LAT = 4096, M_ALL = 12288, L_CTX = 256, L_LAT = 1024, D_IN = 10240, NH = 16, HD = 64;
constexpr float LN_EPS = 1e-5f, ALPHA = 1.189207115002721f, LOG2E = 1.4426950408889634f, C2 = 0.125f * LOG2E;
constexpr float MIN_DECAY = -3.0701134573253945f, MAX_DECAY = -15.350567286626973f;
constexpr size_t MiB = 1u << 20;
constexpr size_t PLANE_E = (size_t)M_ALL * DM;
constexpr size_t WS_CTL = 0, CTL_ZERO_BYTES = 1 * MiB;
constexpr size_t WS_MOD = 1 * MiB;
constexpr size_t WS_WIN = 2 * MiB, WS_WBH = 22 * MiB, WS_WBA = 24 * MiB, WS_WOUT = 26 * MiB;
constexpr size_t WS_RTC = 28 * MiB, WS_RTL = 29 * MiB;
constexpr size_t WS_CK = 34 * MiB, WS_CV = 36 * MiB;
constexpr size_t WS_XN = 38 * MiB;
constexpr size_t WS_PL = 62 * MiB;
constexpr size_t WS_END = 254 * MiB;
constexpr int CW_BAR = 4096;
constexpr int N_PHASES = 9;
constexpr int RING_BYTES = 131072, LDSCTL_OFF = 139264, MISC_OFF = LDSCTL_OFF + 320, LDS_BYTES = 147456;

__device__ __forceinline__ float bf2f(bf16 v) { return __uint_as_float((unsigned)v << 16); }
__device__ __forceinline__ float sigm(float x) { return __builtin_amdgcn_rcpf(1.0f + __builtin_amdgcn_exp2f(-LOG2E * x)); }
__device__ __forceinline__ float wave_sum(float v) {
#pragma unroll
    for (int o = 1; o < 64; o <<= 1) v += __shfl_xor(v, o);
    return v;
}
__device__ __forceinline__ float wave_max(float v) {
#pragma unroll
    for (int o = 1; o < 64; o <<= 1) v = fmaxf(v, __shfl_xor(v, o));
    return v;
}

struct Args { const float* in[24]; float* out; unsigned char* ws; int ph_lo, ph_hi, li, pad; };
enum { I_XP = 0, I_XS, I_C, I_CK, I_CV, I_CCTX, I_WADA, I_BADA, I_WIN, I_CONVW, I_CONVB, I_FW1, I_FB1, I_FW2, I_FB2, I_FW3, I_FFREQ, I_HD, I_RPB, I_WBH, I_WBA, I_WOUT, I_LNG, I_LNB };

__device__ __forceinline__ void p0_transpose_item(const float* W, int K, int N, bf16* WT, LAS float* scr, int item, int lane) {
    const int nblk = N / 32, kb = item / nblk, nb = item % nblk, k0 = 64 * kb, n0 = 32 * nb;
#pragma unroll 8
    for (int i = 0; i < 32; ++i) { const int kk = 2 * i + (lane >> 5); scr[kk * 33 + (lane & 31)] = W[(size_t)(k0 + kk) * N + n0 + (lane & 31)]; }
    LDS_WAIT(); asm volatile("" ::: "memory");
    const int c = lane & 7;
#pragma unroll
    for (int j = 0; j < 4; ++j) { const int n = (lane >> 3) + 8 * j; const LAS float* s = scr + (8 * c) * 33 + n;
        v4u o; o.x = pk2(s[0 * 33], s[1 * 33]); o.y = pk2(s[2 * 33], s[3 * 33]); o.z = pk2(s[4 * 33], s[5 * 33]); o.w = pk2(s[6 * 33], s[7 * 33]);
        *(GAS v4u*)(WT + (size_t)(n0 + n) * K + k0 + 8 * c) = o; }
    LDS_WAIT(); asm volatile("" ::: "memory");
}

__device__ __forceinline__ void phase_prologue(const Args& A, LAS unsigned char* lds) {
    const int tid = threadIdx.x, lane = tid & 63, wave = __builtin_amdgcn_readfirstlane(tid >> 6);
    const int G = gridDim.x, bid = blockIdx.x;
    unsigned char* ws = A.ws;
    for (int task = bid; task < 48; task += G) {
        LAS float* sc = (LAS float*)lds;
        LAS float* red = (LAS float*)(lds + 20480);
        const float* c_ctx = A.in[I_CCTX]; const float* c = A.in[I_C]; const float* w_ada = A.in[I_WADA]; const float* b_ada = A.in[I_BADA];
        float* mod = (float*)(ws + WS_MOD);
        for (int idx = tid; idx < 5 * 1024; idx += NTHREADS) { const int i = idx >> 10, k = idx & 1023; const float v = (i == 0) ? c_ctx[k] : c[(i - 1) * 1024 + k]; sc[idx] = v * sigm(v); }
        __syncthreads();
        const int col = task * 64 + lane;
        float a0 = 0.f, a1 = 0.f, a2 = 0.f, a3 = 0.f, a4 = 0.f;
        const float* wp = w_ada + (size_t)(wave * 128) * 3072 + col;
#pragma unroll 8
        for (int k = 0; k < 128; ++k) { const float w = wp[(size_t)k * 3072]; const int kk = wave * 128 + k;
            a0 += sc[kk] * w; a1 += sc[1024 + kk] * w; a2 += sc[2048 + kk] * w; a3 += sc[3072 + kk] * w; a4 += sc[4096 + kk] * w; }
        red[(wave * 5 + 0) * 64 + lane] = a0; red[(wave * 5 + 1) * 64 + lane] = a1; red[(wave * 5 + 2) * 64 + lane] = a2; red[(wave * 5 + 3) * 64 + lane] = a3; red[(wave * 5 + 4) * 64 + lane] = a4;
        __syncthreads();
        if (tid < 320) { const int i = tid >> 6, l = tid & 63; float s = b_ada[task * 64 + l];
#pragma unroll
            for (int w = 0; w < 8; ++w) s += red[(w * 5 + i) * 64 + l];
            mod[i * 3072 + task * 64 + l] = s; }
        __syncthreads();
    }
    for (int task = G - 1 - bid; task < 160; task += G) {
        if (task < 0) break;
        const int grp = task < 32 ? 0 : 1, L = grp ? L_LAT : L_CTX, i0 = (grp ? task - 32 : task) * 8;
        LAS float* zl = (LAS float*)lds; LAS float* h1l = zl + 512; LAS float* h2l = h1l + 512;
        const float* w1 = A.in[I_FW1]; const float* b1 = A.in[I_FB1]; const float* w2 = A.in[I_FW2]; const float* b2 = A.in[I_FB2]; const float* w3 = A.in[I_FW3]; const float* fq = A.in[I_FFREQ]; const float* hd = A.in[I_HD];
        {
            const int i = i0 + wave;
            const float tpos = (float)i / (float)(L - 1), w = 6.283185307179586f * (float)i / (float)L;
            float zv = 0.f;
            if (lane == 0) zv = tpos;
            else if (lane <= 16) { const float band = 1e-4f + (float)(lane - 1) * ((15.0f - 1e-4f) / 15.0f); zv = cosf(band * w); }
            else if (lane <= 32) { const float band = 1e-4f + (float)(lane - 17) * ((15.0f - 1e-4f) / 15.0f); zv = -sinf(band * w); }
            zl[wave * 64 + lane] = zv;
            LDS_WAIT(); asm volatile("" ::: "memory");
            float a = b1[lane];
#pragma unroll
            for (int e = 0; e < 33; ++e) a += zl[wave * 64 + e] * w1[e * 64 + lane];
            h1l[wave * 64 + lane] = sinf(fq[lane] * a);
            LDS_WAIT(); asm volatile("" ::: "memory");
            a = b2[lane];
#pragma unroll 8
            for (int e = 0; e < 64; ++e) a += h1l[wave * 64 + e] * w2[e * 64 + lane];
            h2l[wave * 64 + lane] = sinf(fq[64 + lane] * a);
        }
        __syncthreads();
        float acc[8][4];
#pragma unroll
        for (int p = 0; p < 8; ++p)
#pragma unroll
            for (int m = 0; m < 4; ++m) acc[p][m] = 0.f;
        for (int k = 0; k < 64; ++k) {
            float wv[4];
#pragma unroll
            for (int m = 0; m < 4; ++m) wv[m] = w3[(size_t)k * 2048 + tid + 512 * m];
#pragma unroll
            for (int p = 0; p < 8; ++p) { const float hv = h2l[p * 64 + k];
#pragma unroll
                for (int m = 0; m < 4; ++m) acc[p][m] += hv * wv[m]; }
        }
        bf16* RT = (bf16*)(ws + (grp ? WS_RTL : WS_RTC)); const int R2L = 2 * L;
#pragma unroll
        for (int m = 0; m < 4; ++m) { const int j = tid + 512 * m, dir = j >> 10, c = j & 1023;
            const float ad = fabsf(MIN_DECAY + (float)c * ((MAX_DECAY - MIN_DECAY) / 1023.0f));
#pragma unroll
            for (int p = 0; p < 8; ++p) { const int ii = i0 + p; const float tpos = (float)ii / (float)(L - 1);
                float val = acc[p][m] * (__expf(-tpos * ad) + 0.05f);
                if (dir == 0) { if (ii == 0) val += hd[c]; RT[(size_t)c * R2L + (L - 1 - ii)] = (bf16)f2bf(val); }
                else { if (ii == 0) RT[(size_t)c * R2L + R2L - 1] = (bf16)0; else RT[(size_t)c * R2L + (L - 1 + ii)] = (bf16)f2bf(val); } } }
        __syncthreads();
    }
    {
        LAS float* scr = (LAS float*)(lds + wave * 16384);
        const int gw = bid * NWAVES + wave, NGW = G * NWAVES;
        constexpr int I_BIG = 16 * 320, I_SM = 16 * 32, NIT = I_BIG + 3 * I_SM;
        for (int it = gw; it < NIT; it += NGW) {
            int r = it;
            if (r < I_BIG) { p0_transpose_item(A.in[I_WIN], 1024, D_IN, (bf16*)(ws + WS_WIN), scr, r, lane); continue; } r -= I_BIG;
            if (r < I_SM) { p0_transpose_item(A.in[I_WBH], 1024, 1024, (bf16*)(ws + WS_WBH), scr, r, lane); continue; } r -= I_SM;
            if (r < I_SM) { p0_transpose_item(A.in[I_WBA], 1024, 1024, (bf16*)(ws + WS_WBA), scr, r, lane); continue; } r -= I_SM;
            p0_transpose_item(A.in[I_WOUT], 1024, 1024, (bf16*)(ws + WS_WOUT), scr, r, lane);
        }
        for (int rr = gw; rr < 2048; rr += NGW) {
            const float* src = (rr < 1024 ? A.in[I_CK] : A.in[I_CV]) + (size_t)(rr & 1023) * 1024;
            bf16* dst = (bf16*)(ws + (rr < 1024 ? WS_CK : WS_CV)) + (size_t)(rr & 1023) * 1024;
#pragma unroll
            for (int j = 0; j < 4; ++j) { const f32x4 v = *(const f32x4*)(src + 256 * j + 4 * lane);
                *(unsigned long long*)(dst + 256 * j + 4 * lane) = (unsigned long long)pk2(v.x, v.y) | ((unsigned long long)pk2(v.z, v.w) << 32); }
        }
    }
}

__device__ __forceinline__ void phase_xn(const Args& A) {
    const int tid = threadIdx.x, lane = tid & 63, wave = __builtin_amdgcn_readfirstlane(tid >> 6);
    const int gw = blockIdx.x * NWAVES + wave, NGW = gridDim.x * NWAVES;
    const float* mod = (const float*)(A.ws + WS_MOD); bf16* XN = (bf16*)(A.ws + WS_XN);
    for (int row = gw; row < M_ALL; row += NGW) {
        const int cond = row < M_CTX ? 0 : 1 + ((row - M_CTX) >> 10);
        const float* x = row < M_CTX ? A.in[I_XP] + (size_t)row * DM : A.in[I_XS] + (size_t)(row - M_CTX) * DM;
        const float* sh = mod + cond * 3072; const float* scl = sh + 1024;
#pragma unroll
        for (int j = 0; j < 4; ++j) { const int o = 256 * j + 4 * lane; const f32x4 v = *(const f32x4*)(x + o), s = *(const f32x4*)(scl + o), b = *(const f32x4*)(sh + o);
            const f32x4 h = v * (s + 1.0f) + b;
            *(unsigned long long*)(XN + (size_t)row * DM + o) = (unsigned long long)pk2(h.x, h.y) | ((unsigned long long)pk2(h.z, h.w) << 32); }
    }
}

__device__ __forceinline__ void phase_hyena_u(const Args& A) {
    const bf16* VH = (const bf16*)(A.ws + WS_PL); const bf16* X1 = VH + PLANE_E; bf16* U = (bf16*)(A.ws + WS_XN);
    const float* cw = A.in[I_CONVW]; const float* cb = A.in[I_CONVB];
    const size_t total = (size_t)128 * M_ALL;
    for (size_t idx = (size_t)blockIdx.x * NTHREADS + threadIdx.x; idx < total; idx += (size_t)gridDim.x * NTHREADS) {
        const int q = (int)(idx / M_ALL), row = (int)(idx % M_ALL);
        int s, L; if (row < M_CTX) { s = row & 255; L = L_CTX; } else { s = (row - M_CTX) & 1023; L = L_LAT; }
        const bool hp = s > 0, hn = s < L - 1;
        float uv[8];
#pragma unroll
        for (int pl = 0; pl < 2; ++pl) {
            const bf16* P = (pl ? X1 : VH) + idx * 8;
            const v4u z = {0u, 0u, 0u, 0u};
            const v4u a0 = hp ? *(const v4u*)(P - 8) : z, a1 = *(const v4u*)P, a2 = hn ? *(const v4u*)(P + 8) : z;
            const unsigned w0[4] = {a0.x, a0.y, a0.z, a0.w}, w1[4] = {a1.x, a1.y, a1.z, a1.w}, w2[4] = {a2.x, a2.y, a2.z, a2.w};
#pragma unroll
            for (int e = 0; e < 8; ++e) { const int col = pl * 1024 + q * 8 + e;
                const float x0 = (e & 1) ? __uint_as_float(w0[e >> 1] & 0xffff0000u) : __uint_as_float(w0[e >> 1] << 16);
                const float x1 = (e & 1) ? __uint_as_float(w1[e >> 1] & 0xffff0000u) : __uint_as_float(w1[e >> 1] << 16);
                const float x2 = (e & 1) ? __uint_as_float(w2[e >> 1] & 0xffff0000u) : __uint_as_float(w2[e >> 1] << 16);
                const float r = cw[col] * x0 + cw[3072 + col] * x1 + cw[6144 + col] * x2 + cb[col];
                uv[e] = pl ? uv[e] * r : r; }
        }
        v4u o; o.x = pk2(uv[0], uv[1]); o.y = pk2(uv[2], uv[3]); o.z = pk2(uv[4], uv[5]); o.w = pk2(uv[6], uv[7]);
        *(v4u*)(U + idx * 8) = o;
    }
}
__device__ __forceinline__ void phase_hyena_conv_naive(const Args& A) {
    const int tid = threadIdx.x, lane = tid & 63, wave = __builtin_amdgcn_readfirstlane(tid >> 6);
    const int gw = blockIdx.x * NWAVES + wave, NGW = gridDim.x * NWAVES;
    const bf16* U = (const bf16*)(A.ws + WS_XN); bf16* PL = (bf16*)(A.ws + WS_PL);
    const bf16* X0 = PL + 2 * PLANE_E; const bf16* GH = PL + 3 * PLANE_E; bf16* HG = PL;
    const float* cw = A.in[I_CONVW]; const float* cb = A.in[I_CONVB];
    for (int task = gw; task < 196608; task += NGW) {
        int tb, b, c, L, rowbase;
        if (task < 131072) { tb = task & 3; b = (task >> 2) & 31; c = task >> 7; L = L_CTX; rowbase = b * 256; }
        else { const int t2 = task - 131072; tb = t2 & 15; b = (t2 >> 4) & 3; c = t2 >> 6; L = L_LAT; rowbase = M_CTX + b * 1024; }
        const int t = tb * 64 + lane;
        const bf16* R = (const bf16*)(A.ws + (L == L_LAT ? WS_RTL : WS_RTC)) + (size_t)c * 2 * L + (L - 1 - t);
        const size_t cbase = ((size_t)(c >> 3) * M_ALL + rowbase) * 8 + (c & 7);
        const bf16* Ub = U + cbase;
        float acc = 0.f;
        for (int s0 = 0; s0 < L; s0 += 64) {
            const float ureg = bf2f(Ub[(size_t)(s0 + lane) * 8]);
#pragma unroll
            for (int j = 0; j < 64; ++j) acc += __uint_as_float(__builtin_amdgcn_readlane(__float_as_uint(ureg), j)) * bf2f(R[s0 + j]);
        }
        const bf16* X0b = X0 + cbase; const bf16* GHb = GH + cbase;
        const float xm = t > 0 ? bf2f(X0b[(size_t)(t - 1) * 8]) : 0.f, xc = bf2f(X0b[(size_t)t * 8]), xp = t < L - 1 ? bf2f(X0b[(size_t)(t + 1) * 8]) : 0.f;
        const float x0c = cw[2048 + c] * xm + cw[3072 + 2048 + c] * xc + cw[6144 + 2048 + c] * xp + cb[2048 + c];
        const float sg = bf2f(GHb[(size_t)t * 8]);
        HG[(size_t)(rowbase + t) * DM + c] = (bf16)f2bf(acc * x0c * sg);
    }
}
namespace att {
typedef short bf16x8 __attribute__((ext_vector_type(8)));
typedef short s16x4 __attribute__((ext_vector_type(4)));
typedef float f32x16 __attribute__((ext_vector_type(16)));
constexpr int KROW = 144, KBUF = 64 * KROW;
constexpr int OFF_K = 0, OFF_V = 2 * KBUF, OFF_OST = 4 * KBUF, OFF_BIAS = OFF_OST + 8 * 4096, LDS_USED = OFF_BIAS + 15 * 128 * 4;
__device__ __forceinline__ s16x4 vtr(LAS const unsigned char* p) { return __builtin_bit_cast(s16x4, __builtin_amdgcn_ds_read_tr16_b64_v4i16((LAS s16x4*)p)); }
__device__ __forceinline__ unsigned cvtpk(float lo, float hi) { typedef float f2 __attribute__((ext_vector_type(2))); typedef __bf16 b2 __attribute__((ext_vector_type(2))); f2 v = {lo, hi}; b2 b = __builtin_convertvector(v, b2); return __builtin_bit_cast(unsigned, b); }

struct StepSrc { const bf16* k; const bf16* v; int dr; bool win; };

__device__ __forceinline__ void attn_unit(const Args& A, LAS unsigned char* lds, int lat, int b, int h, int qb) {
    const int tid = threadIdx.x, lane = tid & 63, wave = __builtin_amdgcn_readfirstlane(tid >> 6), r32 = lane & 31, hi = lane >> 5;
    bf16* PL = (bf16*)(A.ws + WS_PL);
    bf16* Qp = PL + 4 * PLANE_E; const bf16* Kp = PL + 5 * PLANE_E; const bf16* Vp = PL + 6 * PLANE_E; const bf16* GAp = PL + 7 * PLANE_E;
    const bf16* CK = (const bf16*)(A.ws + WS_CK); const bf16* CV = (const bf16*)(A.ws + WS_CV);
    const int rowbase = lat ? M_CTX + b * 1024 + qb * 256 : b * 256;
    const int qrow = rowbase + wave * 32 + r32;
    const int gr = qb * 4 + (wave >> 1), qc = 32 * (wave & 1) + r32;
    const int r0w = min(max(gr - 4, 0), 8), c0 = min(max(qc - 8, 0), 48);
    const int u0 = min(max(qb * 4 - 4, 0), 8), u1 = min(max(qb * 4 + 3 - 4, 0), 8) + 7;
    const int nwin = lat ? (u1 - u0 + 1) : 0, nsteps = nwin + 4;
    bf16x8 qr[4];
#pragma unroll
    for (int ks = 0; ks < 4; ++ks) qr[ks] = *(const bf16x8*)(Qp + (size_t)qrow * DM + h * HD + ks * 16 + hi * 8);
    if (lat) { LAS float* bl = (LAS float*)(lds + OFF_BIAS); const float* rpb = A.in[I_RPB] + h * 15 * 31;
        for (int i = tid; i < 15 * 128; i += NTHREADS) { const int rr = i >> 7, cc = (i & 127) - 48; bl[i] = (cc >= 0 && cc < 31) ? rpb[rr * 31 + cc] * LOG2E : 0.f; } }
    const int skey = tid >> 3, sch = tid & 7;
    auto step_k = [&](int i) -> const bf16* { if (!lat) return Kp + (size_t)(b * 256 + 64 * i) * DM + h * HD; if (i < nwin) return Kp + (size_t)(M_CTX + b * 1024 + (u0 + i) * 64) * DM + h * HD; return CK + (size_t)(b * 256 + 64 * (i - nwin)) * DM + h * HD; };
    auto step_v = [&](int i) -> const bf16* { if (!lat) return Vp + (size_t)(b * 256 + 64 * i) * DM + h * HD; if (i < nwin) return Vp + (size_t)(M_CTX + b * 1024 + (u0 + i) * 64) * DM + h * HD; return CV + (size_t)(b * 256 + 64 * (i - nwin)) * DM + h * HD; };
    v4u kreg = *(const v4u*)(step_k(0) + (size_t)skey * DM + sch * 8), vreg = *(const v4u*)(step_v(0) + (size_t)skey * DM + sch * 8);
    *(LAS v4u*)(lds + OFF_K + skey * KROW + sch * 16) = kreg; *(LAS v4u*)(lds + OFF_V + skey * KROW + sch * 16) = vreg;
    __syncthreads();
    float m_run = -1e30f, l_run = 0.f;
    f32x16 o0 = {}, o1 = {};
    for (int i = 0; i < nsteps; ++i) {
        const int buf = i & 1;
        if (i + 1 < nsteps) { kreg = *(const v4u*)(step_k(i + 1) + (size_t)skey * DM + sch * 8); vreg = *(const v4u*)(step_v(i + 1) + (size_t)skey * DM + sch * 8); }
        const bool win = lat && i < nwin; const int ur = u0 + i;
        const bool active = !win || (ur >= r0w && ur < r0w + 8);
        if (active) {
            LAS const unsigned char* kb = lds + OFF_K + buf * KBUF + r32 * KROW + hi * 16;
            f32x16 s0 = {}, s1 = {};
#pragma unroll
            for (int ks = 0; ks < 4; ++ks) { const bf16x8 k0 = *(LAS const bf16x8*)(kb + ks * 32), k1 = *(LAS const bf16x8*)(kb + 32 * KROW + ks * 32);
                s0 = __builtin_amdgcn_mfma_f32_32x32x16_bf16(k0, qr[ks], s0, 0, 0, 0); s1 = __builtin_amdgcn_mfma_f32_32x32x16_bf16(k1, qr[ks], s1, 0, 0, 0); }
            if (win) { LAS const float* bl = (LAS const float*)(lds + OFF_BIAS) + (ur - gr + 7) * 128 + (15 + 48 - qc + 4 * hi); const int lo = c0 - 4 * hi;
#pragma unroll
                for (int r = 0; r < 16; ++r) { const int kc = (r & 3) + 8 * (r >> 2);
                    s0[r] = ((unsigned)(kc - lo) < 16u) ? s0[r] + bl[kc] : -1e30f;
                    s1[r] = ((unsigned)(kc + 32 - lo) < 16u) ? s1[r] + bl[kc + 32] : -1e30f; } }
            float cm = fmaxf(s0[0], s1[0]);
#pragma unroll
            for (int r = 1; r < 16; ++r) cm = fmaxf(cm, fmaxf(s0[r], s1[r]));
            cm = fmaxf(cm, __shfl_xor(cm, 32));
            const float m_new = fmaxf(m_run, cm), alpha = __builtin_amdgcn_exp2f(m_run - m_new);
            m_run = m_new;
            float ps = 0.f;
#pragma unroll
            for (int r = 0; r < 16; ++r) { s0[r] = __builtin_amdgcn_exp2f(s0[r] - m_new); s1[r] = __builtin_amdgcn_exp2f(s1[r] - m_new); ps += s0[r] + s1[r]; }
            l_run = l_run * alpha + ps;
#pragma unroll
            for (int r = 0; r < 16; ++r) { o0[r] *= alpha; o1[r] *= alpha; }
            bf16x8 pf[4];
#pragma unroll
            for (int s2 = 0; s2 < 4; ++s2) { const f32x16& sv = (s2 < 2) ? s0 : s1; const int rb = 8 * (s2 & 1);
                v4u w; w.x = cvtpk(sv[rb + 0], sv[rb + 1]); w.y = cvtpk(sv[rb + 2], sv[rb + 3]); w.z = cvtpk(sv[rb + 4], sv[rb + 5]); w.w = cvtpk(sv[rb + 6], sv[rb + 7]);
                pf[s2] = __builtin_bit_cast(bf16x8, w); }
            LAS const unsigned char* vb = lds + OFF_V + buf * KBUF + (4 * (lane >> 5) + ((lane & 15) >> 2)) * KROW + (16 * ((lane >> 4) & 1) + 4 * (lane & 3)) * 2;
#pragma unroll
            for (int s2 = 0; s2 < 4; ++s2) {
                const s16x4 a0 = vtr(vb + (16 * s2) * KROW), a1 = vtr(vb + (16 * s2 + 8) * KROW), c0v = vtr(vb + (16 * s2) * KROW + 64), c1v = vtr(vb + (16 * s2 + 8) * KROW + 64);
                const bf16x8 v0 = {a0[0], a0[1], a0[2], a0[3], a1[0], a1[1], a1[2], a1[3]}, v1 = {c0v[0], c0v[1], c0v[2], c0v[3], c1v[0], c1v[1], c1v[2], c1v[3]};
                o0 = __builtin_amdgcn_mfma_f32_32x32x16_bf16(v0, pf[s2], o0, 0, 0, 0); o1 = __builtin_amdgcn_mfma_f32_32x32x16_bf16(v1, pf[s2], o1, 0, 0, 0); }
        }
        if (i + 1 < nsteps) { *(LAS v4u*)(lds + OFF_K + (buf ^ 1) * KBUF + skey * KROW + sch * 16) = kreg; *(LAS v4u*)(lds + OFF_V + (buf ^ 1) * KBUF + skey * KROW + sch * 16) = vreg; }
        __syncthreads();
    }
    l_run += __shfl_xor(l_run, 32);
    const float inv = 1.0f / l_run;
    LAS unsigned char* stg = lds + OFF_OST + wave * 4096;
#pragma unroll
    for (int g = 0; g < 4; ++g) {
        typedef unsigned u2 __attribute__((ext_vector_type(2)));
        u2 w0 = {cvtpk(o0[4 * g] * inv, o0[4 * g + 1] * inv), cvtpk(o0[4 * g + 2] * inv, o0[4 * g + 3] * inv)}, w1 = {cvtpk(o1[4 * g] * inv, o1[4 * g + 1] * inv), cvtpk(o1[4 * g + 2] * inv, o1[4 * g + 3] * inv)};
        *(LAS u2*)(stg + r32 * 128 + (8 * g + 4 * hi) * 2) = w0; *(LAS u2*)(stg + r32 * 128 + (32 + 8 * g + 4 * hi) * 2) = w1; }
    LDS_WAIT(); asm volatile("" ::: "memory");
#pragma unroll
    for (int i = 0; i < 4; ++i) { const int row = 8 * i + (lane >> 3), ch = lane & 7;
        const v4u ov = *(LAS const v4u*)(stg + row * 128 + ch * 16);
        const size_t go = (size_t)(rowbase + wave * 32 + row) * DM + h * HD + ch * 8;
        const v4u gv = *(const v4u*)(GAp + go);
        v4u r; r.x = cvtpk(pg8::bf_lo(ov.x) * pg8::bf_lo(gv.x), pg8::bf_hi(ov.x) * pg8::bf_hi(gv.x)); r.y = cvtpk(pg8::bf_lo(ov.y) * pg8::bf_lo(gv.y), pg8::bf_hi(ov.y) * pg8::bf_hi(gv.y));
        r.z = cvtpk(pg8::bf_lo(ov.z) * pg8::bf_lo(gv.z), pg8::bf_hi(ov.z) * pg8::bf_hi(gv.z)); r.w = cvtpk(pg8::bf_lo(ov.w) * pg8::bf_lo(gv.w), pg8::bf_hi(ov.w) * pg8::bf_hi(gv.w));
        *(v4u*)(Qp + go) = r; }
    __syncthreads();
}
__device__ __forceinline__ void phase_attn(const Args& A, LAS unsigned char* lds) {
    for (int u = blockIdx.x; u < 768; u += gridDim.x) {
        if (u < 256) { const int qb = (u & 1) ? ((u >> 1) & 1) * 3 : 1 + ((u >> 1) & 1);
            const int bh = u >> 2; attn_unit(A, lds, 1, bh >> 4, bh & 15, qb); }
        else { const int bh = u - 256; attn_unit(A, lds, 0, bh >> 4, bh & 15, 0); }
    }
}
}
namespace hy {
typedef short bf16x8 __attribute__((ext_vector_type(8)));
typedef float f32x16 __attribute__((ext_vector_type(16)));
constexpr int OFF_U = 0, OFF_E = 69632, LDS_USED = OFF_E + 65536;
template <int L, int NB, int TB, int CPP, int NTW>
__device__ __forceinline__ void unit(const Args& A, LAS unsigned char* lds, int q, int rowbase) {
    constexpr int SU = L + 8, NBLK = L / 32, NPASS = 8 / CPP, NROWS = NB * L;
    static_assert(NB * TB == 32 && NROWS == 4096 && CPP * 2 * L * 16 == 65536 && 8 * NB * SU * 2 <= OFF_E, "hyena unit geometry");
    const int tid = threadIdx.x, lane = tid & 63, wave = __builtin_amdgcn_readfirstlane(tid >> 6), r32 = lane & 31, hi = lane >> 5;
    const bf16* PL = (const bf16*)(A.ws + WS_PL);
    const bf16* VH = PL; const bf16* X1 = PL + PLANE_E; const bf16* X0 = PL + 2 * PLANE_E; const bf16* GH = PL + 3 * PLANE_E;
    bf16* HG = (bf16*)(A.ws + WS_XN);
    const bf16* RT = (const bf16*)(A.ws + (L == L_LAT ? WS_RTL : WS_RTC));
    const float* cw = A.in[I_CONVW]; const float* cb = A.in[I_CONVB];
    LAS bf16* U = (LAS bf16*)(lds + OFF_U);
#pragma unroll 2
    for (int idx = tid; idx < NROWS; idx += NTHREADS) {
        const int b = idx / L, s = idx % L; const size_t go = ((size_t)q * M_ALL + rowbase + idx) * 8;
        const bool hp = s > 0, hn = s < L - 1;
        float uv[8];
#pragma unroll
        for (int pl = 0; pl < 2; ++pl) {
            const bf16* P = (pl ? X1 : VH) + go;
            const v4u z = {0u, 0u, 0u, 0u};
            const v4u a0 = hp ? *(const v4u*)(P - 8) : z, a1 = *(const v4u*)P, a2 = hn ? *(const v4u*)(P + 8) : z;
            const unsigned w0[4] = {a0.x, a0.y, a0.z, a0.w}, w1[4] = {a1.x, a1.y, a1.z, a1.w}, w2[4] = {a2.x, a2.y, a2.z, a2.w};
#pragma unroll
            for (int e = 0; e < 8; ++e) { const int col = pl * 1024 + q * 8 + e;
                const float x0 = (e & 1) ? pg8::bf_hi(w0[e >> 1]) : pg8::bf_lo(w0[e >> 1]), x1 = (e & 1) ? pg8::bf_hi(w1[e >> 1]) : pg8::bf_lo(w1[e >> 1]), x2 = (e & 1) ? pg8::bf_hi(w2[e >> 1]) : pg8::bf_lo(w2[e >> 1]);
                const float r = cw[col] * x0 + cw[3072 + col] * x1 + cw[6144 + col] * x2 + cb[col];
                uv[e] = pl ? uv[e] * r : r; }
        }
#pragma unroll
        for (int e = 0; e < 8; ++e) U[(e * NB + b) * SU + s] = (bf16)f2bf(uv[e]);
    }
    f32x16 acc[NTW];
    const int cc = (NTW == 4) ? wave : (wave >> 2), nt0 = (NTW == 4) ? 0 : (wave & 3);
    for (int p = 0; p < NPASS; ++p) {
#pragma unroll 1
        for (int it = tid; it < CPP * (L - 4); it += NTHREADS) { const int c = it / (L - 4), pp = it % (L - 4);
            const unsigned* RD = (const unsigned*)(RT + (size_t)(q * 8 + p * CPP + c) * 2 * L) + pp;
            const unsigned d0 = RD[0], d1 = RD[1], d2 = RD[2], d3 = RD[3], d4 = RD[4];
            v4u e0 = {d0, d1, d2, d3}, e1 = {__builtin_amdgcn_alignbit(d1, d0, 16), __builtin_amdgcn_alignbit(d2, d1, 16), __builtin_amdgcn_alignbit(d3, d2, 16), __builtin_amdgcn_alignbit(d4, d3, 16)};
            LAS v4u* E = (LAS v4u*)(lds + OFF_E) + c * 2 * L + 2 * pp; E[0] = e0; E[1] = e1; }
        __syncthreads();
        const int ch = p * CPP + cc;
#pragma unroll
        for (int j = 0; j < NTW; ++j) acc[j] = f32x16{};
        LAS const unsigned char* Eb = lds + OFF_E + (size_t)cc * 2 * L * 16 + (L - 1 - r32 + 8 * hi) * 16;
        const int d1_lo = TB * nt0 - (NBLK - 1), d1_hi = TB * (nt0 + NTW - 1) + TB - 1;
#pragma unroll 1
        for (int d1 = d1_lo; d1 <= d1_hi; ++d1) {
#pragma unroll
            for (int kk = 0; kk < 2; ++kk) {
                const bf16x8 af = *(LAS const bf16x8*)(Eb + (-32 * d1 + 16 * kk) * 16);
#pragma unroll
                for (int j = 0; j < NTW; ++j) { const int nt = nt0 + j;
                    if (d1 >= TB * nt - (NBLK - 1) && d1 <= TB * nt + TB - 1) {
                        const int t1 = TB * nt + r32 / NB, bb = r32 % NB, sb = t1 - d1; const bool ok = (unsigned)sb < (unsigned)NBLK;
                        const int sbc = ok ? sb : 0;
                        bf16x8 bfr = *(LAS const bf16x8*)(U + (ch * NB + bb) * SU + 32 * sbc + 16 * kk + 8 * hi);
                        if (!ok) bfr = bf16x8{};
                        acc[j] = __builtin_amdgcn_mfma_f32_32x32x16_bf16(af, bfr, acc[j], 0, 0, 0); } }
            }
        }
        __syncthreads();
#pragma unroll
        for (int j = 0; j < NTW; ++j) { const int nt = nt0 + j, t1 = TB * nt + r32 / NB, bb = r32 % NB;
#pragma unroll
            for (int g = 0; g < 4; ++g) { typedef unsigned u2 __attribute__((ext_vector_type(2)));
                u2 w = {att::cvtpk(acc[j][4 * g], acc[j][4 * g + 1]), att::cvtpk(acc[j][4 * g + 2], acc[j][4 * g + 3])};
                *(LAS u2*)(U + (ch * NB + bb) * SU + 32 * t1 + 8 * g + 4 * hi) = w; } }
    }
    __syncthreads();
#pragma unroll 2
    for (int idx = tid; idx < NROWS; idx += NTHREADS) {
        const int b = idx / L, s = idx % L; const size_t go = ((size_t)q * M_ALL + rowbase + idx) * 8;
        const bool hp = s > 0, hn = s < L - 1;
        const v4u z = {0u, 0u, 0u, 0u};
        const v4u a0 = hp ? *(const v4u*)(X0 + go - 8) : z, a1 = *(const v4u*)(X0 + go), a2 = hn ? *(const v4u*)(X0 + go + 8) : z, gg = *(const v4u*)(GH + go);
        const unsigned w0[4] = {a0.x, a0.y, a0.z, a0.w}, w1[4] = {a1.x, a1.y, a1.z, a1.w}, w2[4] = {a2.x, a2.y, a2.z, a2.w}, wg[4] = {gg.x, gg.y, gg.z, gg.w};
        float ov[8];
#pragma unroll
        for (int e = 0; e < 8; ++e) { const int col = 2048 + q * 8 + e;
            const float x0 = (e & 1) ? pg8::bf_hi(w0[e >> 1]) : pg8::bf_lo(w0[e >> 1]), x1 = (e & 1) ? pg8::bf_hi(w1[e >> 1]) : pg8::bf_lo(w1[e >> 1]), x2 = (e & 1) ? pg8::bf_hi(w2[e >> 1]) : pg8::bf_lo(w2[e >> 1]);
            const float sg = (e & 1) ? pg8::bf_hi(wg[e >> 1]) : pg8::bf_lo(wg[e >> 1]);
            const float x0c = cw[col] * x0 + cw[3072 + col] * x1 + cw[6144 + col] * x2 + cb[col];
            ov[e] = bf2f(U[(e * NB + b) * SU + s]) * x0c * sg; }
        v4u o; o.x = att::cvtpk(ov[0], ov[1]); o.y = att::cvtpk(ov[2], ov[3]); o.z = att::cvtpk(ov[4], ov[5]); o.w = att::cvtpk(ov[6], ov[7]);
        *(v4u*)(HG + go) = o;
    }
    __syncthreads();
}
}
__device__ __forceinline__ void phase_mix(const Args& A, LAS unsigned char* lds) {
    for (int u = blockIdx.x; u < 1152; u += gridDim.x) {
        if (u < 128) hy::unit<L_LAT, 4, 8, 2, 1>(A, lds, u, M_CTX);
        else if (u < 384) { const int v = u - 128; const int qb = (v & 1) ? ((v >> 1) & 1) * 3 : 1 + ((v >> 1) & 1); const int bh = v >> 2; att::attn_unit(A, lds, 1, bh >> 4, bh & 15, qb); }
        else if (u < 640) { const int v = u - 384; hy::unit<L_CTX, 16, 2, 8, 4>(A, lds, v >> 1, (v & 1) * 4096); }
        else { const int bh = u - 640; att::attn_unit(A, lds, 0, bh >> 4, bh & 15, 0); }
    }
}
__device__ __forceinline__ float dot64(const float (&q)[64], const bf16* k) {
    float s = 0.f;
#pragma unroll
    for (int i = 0; i < 8; ++i) { const v4u w = *(const v4u*)(k + 8 * i);
        s += q[8 * i + 0] * __uint_as_float(w.x << 16) + q[8 * i + 1] * __uint_as_float(w.x & 0xffff0000u) + q[8 * i + 2] * __uint_as_float(w.y << 16) + q[8 * i + 3] * __uint_as_float(w.y & 0xffff0000u)
           + q[8 * i + 4] * __uint_as_float(w.z << 16) + q[8 * i + 5] * __uint_as_float(w.z & 0xffff0000u) + q[8 * i + 6] * __uint_as_float(w.w << 16) + q[8 * i + 7] * __uint_as_float(w.w & 0xffff0000u); }
    return s;
}
__device__ __forceinline__ void phase_attn_naive(const Args& A) {
    const int tid = threadIdx.x, lane = tid & 63, wave = __builtin_amdgcn_readfirstlane(tid >> 6);
    const int gw = blockIdx.x * NWAVES + wave, NGW = gridDim.x * NWAVES;
    bf16* PL = (bf16*)(A.ws + WS_PL);
    bf16* Q = PL + 4 * PLANE_E; const bf16* K = PL + 5 * PLANE_E; const bf16* V = PL + 6 * PLANE_E; const bf16* GA = PL + 7 * PLANE_E;
    const bf16* CK = (const bf16*)(A.ws + WS_CK); const bf16* CV = (const bf16*)(A.ws + WS_CV);
    const float* rpb = A.in[I_RPB];
    for (int task = gw; task < M_ALL * NH; task += NGW) {
        const int row = task >> 4, h = task & 15;
        float q[64];
        { const bf16* qp = Q + (size_t)row * DM + h * HD;
#pragma unroll
          for (int i = 0; i < 8; ++i) { const v4u w = *(const v4u*)(qp + 8 * i);
              q[8 * i + 0] = __uint_as_float(w.x << 16); q[8 * i + 1] = __uint_as_float(w.x & 0xffff0000u); q[8 * i + 2] = __uint_as_float(w.y << 16); q[8 * i + 3] = __uint_as_float(w.y & 0xffff0000u);
              q[8 * i + 4] = __uint_as_float(w.z << 16); q[8 * i + 5] = __uint_as_float(w.z & 0xffff0000u); q[8 * i + 6] = __uint_as_float(w.w << 16); q[8 * i + 7] = __uint_as_float(w.w & 0xffff0000u); } }
        float sc[6]; int vrow[6];
        const bool lat = row >= M_CTX;
        if (!lat) { const int b = row >> 8;
#pragma unroll
            for (int j = 0; j < 4; ++j) { vrow[j] = b * 256 + j * 64 + lane; sc[j] = dot64(q, K + (size_t)vrow[j] * DM + h * HD); }
            sc[4] = -INFINITY; sc[5] = -INFINITY; vrow[4] = 0; vrow[5] = 0;
        } else { const int rl = row - M_CTX, b = rl >> 10, pos = rl & 1023, gr = pos >> 6, gc = pos & 63;
            const int r0 = min(max(gr - 4, 0), 8), c0 = min(max(gc - 8, 0), 48);
#pragma unroll
            for (int j = 0; j < 2; ++j) { const int kr = r0 + j * 4 + (lane >> 4), kc = c0 + (lane & 15); vrow[j] = M_CTX + b * 1024 + kr * 64 + kc;
                const float bias = rpb[(h * 15 + (kr - gr + 7)) * 31 + (kc - gc + 15)] * LOG2E;
                sc[j] = dot64(q, K + (size_t)vrow[j] * DM + h * HD) + bias; }
#pragma unroll
            for (int j = 0; j < 4; ++j) { vrow[2 + j] = b * 256 + j * 64 + lane; sc[2 + j] = dot64(q, CK + (size_t)vrow[2 + j] * DM + h * HD); }
        }
        float m = sc[0];
#pragma unroll
        for (int j = 1; j < 6; ++j) m = fmaxf(m, sc[j]);
        m = wave_max(m);
        float l = 0.f;
#pragma unroll
        for (int j = 0; j < 6; ++j) { sc[j] = __builtin_amdgcn_exp2f(sc[j] - m); l += sc[j]; }
        l = wave_sum(l);
        float o = 0.f;
#pragma unroll
        for (int j = 0; j < 6; ++j) {
            if (!lat && j >= 4) continue;
            const bf16* Vb = (lat && j >= 2) ? CV : V;
            for (int kk = 0; kk < 64; ++kk) { const float pk = __shfl(sc[j], kk); const int vr = __shfl(vrow[j], kk);
                o += pk * bf2f(Vb[(size_t)vr * DM + h * HD + lane]); }
        }
        const size_t oo = (size_t)row * DM + h * HD + lane;
        Q[oo] = (bf16)f2bf(o / l * bf2f(GA[oo]));
    }
}

__device__ __forceinline__ void phase_ln(const Args& A) {
    const int tid = threadIdx.x, lane = tid & 63, wave = __builtin_amdgcn_readfirstlane(tid >> 6);
    const int gw = blockIdx.x * NWAVES + wave, NGW = gridDim.x * NWAVES;
    const float* g = A.in[I_LNG]; const float* be = A.in[I_LNB];
    for (int row = gw; row < M_ALL; row += NGW) {
        float* y = A.out + (size_t)row * DM;
        f32x4 v[4]; float s = 0.f;
#pragma unroll
        for (int j = 0; j < 4; ++j) { v[j] = *(const f32x4*)(y + 256 * j + 4 * lane); s += (v[j].x + v[j].y) + (v[j].z + v[j].w); }
        const float mean = wave_sum(s) * (1.f / DM); float s2 = 0.f;
#pragma unroll
        for (int j = 0; j < 4; ++j) { v[j] = v[j] - mean; s2 += (v[j].x * v[j].x + v[j].y * v[j].y) + (v[j].z * v[j].z + v[j].w * v[j].w); }
        const float rstd = 1.f / sqrtf(wave_sum(s2) * (1.f / DM) + LN_EPS);
#pragma unroll
        for (int j = 0; j < 4; ++j) { const f32x4 gg = *(const f32x4*)(g + 256 * j + 4 * lane), bb = *(const f32x4*)(be + 256 * j + 4 * lane);
            *(f32x4*)(y + 256 * j + 4 * lane) = v[j] * rstd * gg + bb; }
    }
}

__global__ void __launch_bounds__(NWAVES * 64, 2) fwd_kernel(Args args) {
    extern __shared__ __attribute__((aligned(16))) unsigned char lds_raw[];
    LAS unsigned char* lds = (LAS unsigned char*)lds_raw;
    const int tid = threadIdx.x;
    for (int u = tid; u < (LDS_BYTES - LDSCTL_OFF) / 4; u += NWAVES * 64) ((LAS unsigned*)(lds + LDSCTL_OFF))[u] = 0u;
    __syncthreads();
    const int lo = args.ph_lo, hi = args.ph_hi;
    const bool use_bar = (hi - lo) > 1;
    gu32* ctl = (gu32*)(args.ws + WS_CTL);
    XcdBarrier bar; bar.bar = (unsigned*)(ctl + CW_BAR) + args.li * XCD_BAR_WORDS; bar.x = 0; bar.st = nullptr;
    if (use_bar) bar = xcd_barrier_post((unsigned*)(ctl + CW_BAR) + args.li * XCD_BAR_WORDS, (volatile LAS unsigned*)(lds + MISC_OFF) + 8);
#define IN(k) (lo <= (k) && (k) < hi)
#define SEAM(k) do { if (IN(k) && IN((k) + 1)) xcd_barrier(bar); } while (0)
    bf16* PL = (bf16*)(args.ws + WS_PL);
    if (IN(0)) { phase_prologue(args, lds); SEAM(0); }
    if (IN(1)) { phase_xn(args); SEAM(1); }
    if (IN(2)) {
        pg8::Gemm g{(const bf16*)(args.ws + WS_XN), (const bf16*)(args.ws + WS_WIN), M_ALL, D_IN, DM}; pg8::StaticOrder S; S.init(M_ALL, D_IN, gridDim.x, (int)blockIdx.x);
        pg8::EpiProj E{PL, (bf16*)args.out, args.out + (size_t)M_ALL * DM, args.out + (size_t)M_ALL * DM + (size_t)M_CTX * DM, C2};
        pg8::gemm_phase<pg8::EpiProj, pg8::StaticOrder, true, true>(lds, g, S, E);
        SEAM(2);
    }
    if (IN(3)) { SEAM(3); }
    if (IN(4)) { phase_mix(args, lds); SEAM(4); }
    if (IN(5)) {
        pg8::Gemm g{(const bf16*)(args.ws + WS_XN), (const bf16*)(args.ws + WS_WBH), M_ALL, DM, DM}; pg8::StaticOrder S; S.init(M_ALL, DM, gridDim.x, (int)blockIdx.x);
        pg8::EpiGate E{(const bf16*)args.out, nullptr, PL + PLANE_E};
        pg8::gemm_phase<pg8::EpiGate, pg8::StaticOrder, true, true, true>(lds, g, S, E);
        SEAM(5);
    }
    if (IN(6)) {
        pg8::Gemm g{PL + 4 * PLANE_E, (const bf16*)(args.ws + WS_WBA), M_ALL, DM, DM}; pg8::StaticOrder S; S.init(M_ALL, DM, gridDim.x, (int)blockIdx.x);
        pg8::EpiGate E{(const bf16*)args.out + PLANE_E, PL + PLANE_E, PL + 2 * PLANE_E};
        pg8::gemm_phase<pg8::EpiGate, pg8::StaticOrder, true, true>(lds, g, S, E);
        SEAM(6);
    }
    if (IN(7)) {
        pg8::Gemm g{PL + 2 * PLANE_E, (const bf16*)(args.ws + WS_WOUT), M_ALL, DM, DM}; pg8::StaticOrder S; S.init(M_ALL, DM, gridDim.x, (int)blockIdx.x);
        pg8::EpiResid E{args.in[I_XP], args.in[I_XS], (const float*)(args.ws + WS_MOD), args.out, ALPHA};
        pg8::gemm_phase<pg8::EpiResid, pg8::StaticOrder, true, true>(lds, g, S, E);
        SEAM(7);
    }
    if (IN(8)) { phase_ln(args); }
#undef IN
#undef SEAM
}

#ifndef N_LAUNCH_MODE
#define N_LAUNCH_MODE 1
#endif
extern "C" void kernel_launch(void* const* d_in, const int* in_sizes, int n_in, void* d_out, int out_size, void* d_ws, size_t ws_size, hipStream_t stream) {
    static int grid = 0;
    if (grid == 0) {
        if (n_in != 24 || ws_size < WS_END) { fprintf(stderr, "kernel_launch: unexpected n_in %d / ws_size %zu\n", n_in, ws_size); grid = -1; return; }
        int dev = 0, cus = 0, per_cu = 0;
        if (hipGetDevice(&dev) != hipSuccess || hipDeviceGetAttribute(&cus, hipDeviceAttributeMultiprocessorCount, dev) != hipSuccess) { grid = -1; return; }
        if (hipFuncSetAttribute((const void*)fwd_kernel, hipFuncAttributeMaxDynamicSharedMemorySize, LDS_BYTES) != hipSuccess) { fprintf(stderr, "kernel_launch: hipFuncSetAttribute failed\n"); grid = -1; return; }
        if (hipOccupancyMaxActiveBlocksPerMultiprocessor(&per_cu, (const void*)fwd_kernel, NWAVES * 64, LDS_BYTES) != hipSuccess || per_cu < 1) { fprintf(stderr, "kernel_launch: occupancy query says %d blocks per CU\n", per_cu); per_cu = 1; }
        (void)hipGetLastError();
        grid = cus;
    }
    if (grid < 0) return;
    (void)hipMemsetAsync((char*)d_ws + WS_CTL, 0, CTL_ZERO_BYTES, stream);
    Args a{};
    for (int i = 0; i < 24; ++i) a.in[i] = (const float*)d_in[i];
    a.out = (float*)d_out; a.ws = (unsigned char*)d_ws;
    if (N_LAUNCH_MODE == 1) {
        a.ph_lo = 0; a.ph_hi = N_PHASES; a.li = 0;
        hipLaunchKernelGGL(fwd_kernel, dim3(grid), dim3(NWAVES * 64), LDS_BYTES, stream, a);
    } else {
        for (int p = 0; p < N_PHASES; ++p) { a.ph_lo = p; a.ph_hi = p + 1; a.li = 0;
            hipLaunchKernelGGL(fwd_kernel, dim3(grid), dim3(NWAVES * 64), LDS_BYTES, stream, a); }
    }
}
```
